# Optimizing an MI355X kernel written in HIP

```python
import jax, jax.numpy as jnp
from jax import lax
import numpy as np

D_MODEL = 1024
BATCH = 8
SEQ = 2048
DEPTH = 4

CHUNK = 64
EPS = 1e-6
N_HEADS = 4
HEAD_DIM = 64
MIX_W = N_HEADS * HEAD_DIM
N_BRANCH = 4
ATT_LEFT_CHUNKS = 8
ATT_BAND = (ATT_LEFT_CHUNKS + 1) * CHUNK
REL_MAX = 256
REL_SIZE = REL_MAX + CHUNK
NEG_BIG = -1e30
HG_BLOCK = 16
LOG_FLOOR = 1e-30
GM_BLOCK = 128
GM_GROUPS = N_HEADS
GM_GROUP_W = MIX_W // GM_GROUPS
CONV_W = 4
LRU_C = 8.0
FFN_HIDDEN = ((8 * D_MODEL // 3 + 255) // 256) * 256
IN_SIZES = [MIX_W] * 11 + [N_BRANCH * D_MODEL]
IN_COLS = sum(IN_SIZES)

kernel_name = 'hybrid_chunk_causal_parallel_mixer'


def rms_norm(x, g):
    xf = x.astype(jnp.float32)
    y = xf * lax.rsqrt(jnp.mean(xf * xf, axis=-1, keepdims=True) + EPS)
    return (y * g.astype(jnp.float32)).astype(x.dtype)


def split_in(z):
    idx = np.cumsum(IN_SIZES)[:-1].tolist()
    return jnp.split(z, idx, axis=-1)


def chunk_band_attention(q, k, v, rel_bias):
    B, S, _ = q.shape
    nc = S // CHUNK
    L = ATT_LEFT_CHUNKS
    pad = L * CHUNK
    qc = q.reshape(B, nc, CHUNK, N_HEADS, HEAD_DIM)

    def band(t):
        tp = jnp.pad(t, ((0, 0), (pad, 0), (0, 0))).reshape(B, nc + L, CHUNK, N_HEADS, HEAD_DIM)
        return jnp.concatenate([tp[:, j:j + nc] for j in range(L + 1)], axis=2)

    kb, vb = band(k), band(v)
    s = jnp.einsum('bcqhd,bckhd->bchqk', qc, kb).astype(jnp.float32) * (HEAD_DIM ** -0.5)
    dist = pad + jnp.arange(CHUNK)[:, None] - jnp.arange(ATT_BAND)[None, :]
    idx = jnp.clip(dist, -(CHUNK - 1), REL_MAX) + (CHUNK - 1)
    bias = rel_bias.astype(jnp.float32)[:, idx]
    key_pos = jnp.arange(nc)[:, None] * CHUNK + jnp.arange(ATT_BAND)[None, :] - pad
    valid = key_pos >= 0
    s = jnp.where(valid[None, :, None, None, :], s + bias[None, None], NEG_BIG)
    p = jax.nn.softmax(s, axis=-1).astype(v.dtype)
    o = jnp.einsum('bchqk,bckhd->bcqhd', p, vb)
    return o.reshape(B, S, MIX_W)


def hgrn2(q, fz, i, g, lb, norm_g):
    B, S, _ = q.shape
    n = S // HG_BLOCK
    f32 = jnp.float32
    fz = fz.astype(f32)
    lb = lb.astype(f32)
    qf = jax.nn.silu(q.astype(f32))
    f = lb + (1.0 - lb) * jax.nn.sigmoid(fz)
    log_f = jnp.log(jnp.maximum(f, LOG_FLOOR))
    kf = (1.0 - lb) * jax.nn.sigmoid(-fz)
    shp = (B, n, HG_BLOCK, N_HEADS, HEAD_DIM)
    qf, kf, log_f = qf.reshape(shp), kf.reshape(shp), log_f.reshape(shp)
    vf = i.astype(f32).reshape(shp)
    b = jnp.cumsum(log_f, axis=2)
    causal = jnp.tril(jnp.ones((HG_BLOCK, HG_BLOCK), bool))[:, :, None, None]
    diff = b[:, :, :, None] - b[:, :, None, :]
    decay = jnp.where(causal, jnp.exp(jnp.where(causal, diff, 0.0)), 0.0)
    scores = jnp.einsum('bntshk,bnthk,bnshk->bnhts', decay, qf, kf)
    intra = jnp.einsum('bnhts,bnshv->bnthv', scores, vf)
    b_last = b[:, :, -1:]
    qd = qf * jnp.exp(b)
    kd = kf * jnp.exp(b_last - b)
    dec = jnp.exp(b_last[:, :, 0])

    def step(state, xs):
        qd_c, kd_c, v_c, dec_c = xs
        inter_c = jnp.einsum('bthk,bhkv->bthv', qd_c, state)
        state = dec_c[..., None] * state + jnp.einsum('bshk,bshv->bhkv', kd_c, v_c)
        return state, inter_c

    s0 = jnp.zeros((B, N_HEADS, HEAD_DIM, HEAD_DIM), f32)
    xs = (jnp.moveaxis(qd, 1, 0), jnp.moveaxis(kd, 1, 0), jnp.moveaxis(vf, 1, 0), jnp.moveaxis(dec, 1, 0))
    _, inter = lax.scan(step, s0, xs)
    o = (intra + jnp.moveaxis(inter, 0, 1)).reshape(B, S, N_HEADS, HEAD_DIM)
    o = o * lax.rsqrt(jnp.mean(o * o, axis=-1, keepdims=True) + EPS)
    o = o * norm_g.astype(f32).reshape(N_HEADS, HEAD_DIM)
    o = o.reshape(B, S, MIX_W) * jax.nn.silu(g.astype(f32))
    return o.astype(q.dtype)


def spatial_gating(u, v, norm_g, ws, bs):
    B, S, _ = u.shape
    n = S // GM_BLOCK
    vn = rms_norm(v, norm_g).reshape(B, n, GM_BLOCK, GM_GROUPS, GM_GROUP_W)
    w = ws * jnp.tril(jnp.ones((GM_BLOCK, GM_BLOCK), ws.dtype))
    mixed = jnp.einsum('gpq,bnqgc->bnpgc', w, vn) + bs.T[:, :, None]
    return u * mixed.reshape(B, S, MIX_W)


def rg_lru_branch(xin, gate, conv_w, conv_b, wa, ba, wx, bx, lam):
    B, S, _ = xin.shape
    f32 = jnp.float32
    xp = jnp.pad(xin, ((0, 0), (CONV_W - 1, 0), (0, 0)))
    xc = conv_b + xp[:, 0:S] * conv_w[0]
    for j in range(1, CONV_W):
        xc = xc + xp[:, j:j + S] * conv_w[j]
    xh = xc.reshape(B, S, N_HEADS, HEAD_DIM)
    r = jax.nn.sigmoid(jnp.einsum('bshi,hij->bshj', xh, wa).reshape(B, S, MIX_W) + ba)
    ig = jax.nn.sigmoid(jnp.einsum('bshi,hij->bshj', xh, wx).reshape(B, S, MIX_W) + bx)
    log_a = -LRU_C * r.astype(f32) * jax.nn.softplus(-lam.astype(f32))
    a = jnp.exp(log_a)
    mult = jnp.sqrt(jnp.maximum(-jnp.expm1(2.0 * log_a), 0.0))
    mult = jnp.where(jnp.arange(S)[None, :, None] == 0, 1.0, mult)
    bt = mult * (ig * xc).astype(f32)

    def combine(left, right):
        a1, b1 = left
        a2, b2 = right
        return a1 * a2, a2 * b1 + b2

    _, h = lax.associative_scan(combine, (a, bt), axis=1)
    return (h * jax.nn.gelu(gate.astype(f32))).astype(xin.dtype)


def hybrid_mixer(h, w_in, rel_bias, lb, hg_norm_g, gm_norm_g, gm_ws, gm_bs,
                 conv_w, conv_b, wa, ba, wx, bx, lam, w_branch, w_out):
    B, S, _ = h.shape
    z = h @ w_in
    aq, ak, av, bq, bf, bi, bg, cu, cv, dx, dg, gates = split_in(z)
    o_a = chunk_band_attention(aq, ak, av, rel_bias)
    o_b = hgrn2(bq, bf, bi, bg, lb, hg_norm_g)
    o_c = spatial_gating(jax.nn.gelu(cu), jax.nn.gelu(cv), gm_norm_g, gm_ws, gm_bs)
    o_d = rg_lru_branch(dx, dg, conv_w, conv_b, wa, ba, wx, bx, lam)
    outs = jnp.stack([o_a, o_b, o_c, o_d], axis=2)
    proj = jnp.einsum('bsnw,nwd->bsnd', outs, w_branch)
    g = jax.nn.sigmoid(gates.reshape(B, S, N_BRANCH, D_MODEL))
    merged = jnp.sum(g * proj, axis=2)
    return merged @ w_out


def swiglu(h, w1, w2):
    gt, up = jnp.split(h @ w1, 2, axis=-1)
    return (jax.nn.silu(gt) * up) @ w2


def setup_inputs(seed: int = 0) -> dict:
    key = jax.random.key(seed)
    ks = jax.random.split(key, 24)
    f32 = jnp.float32

    def nrm(k, shape, scale):
        return jax.random.normal(k, shape, f32) * scale

    u = jax.random.uniform(ks[18], (DEPTH, MIX_W), f32, 0.9, 0.999)
    sa = u ** (1.0 / LRU_C)
    return {
        'x': nrm(ks[0], (BATCH, SEQ, D_MODEL), 1.0),
        'norm_mix_pre': 1.0 + nrm(ks[1], (DEPTH, D_MODEL), 0.02),
        'norm_mix_post': 1.0 + nrm(ks[2], (DEPTH, D_MODEL), 0.02),
        'norm_ffn_pre': 1.0 + nrm(ks[3], (DEPTH, D_MODEL), 0.02),
        'norm_ffn_post': 1.0 + nrm(ks[4], (DEPTH, D_MODEL), 0.02),
        'w_in': nrm(ks[5], (DEPTH, D_MODEL, IN_COLS), D_MODEL ** -0.5),
        'attn_rel_bias': nrm(ks[6], (DEPTH, N_HEADS, REL_SIZE), 0.1),
        'hgrn_lb_logits': nrm(ks[7], (DEPTH, MIX_W), 1.0),
        'hgrn_norm_g': 1.0 + nrm(ks[8], (DEPTH, MIX_W), 0.02),
        'gmlp_norm_g': 1.0 + nrm(ks[9], (DEPTH, MIX_W), 0.02),
        'gmlp_ws': nrm(ks[10], (DEPTH, GM_GROUPS, GM_BLOCK, GM_BLOCK), 0.5 * GM_BLOCK ** -0.5),
        'gmlp_bs': 1.0 + nrm(ks[11], (DEPTH, GM_GROUPS, GM_BLOCK), 0.01),
        'lru_conv_w': nrm(ks[12], (DEPTH, CONV_W, MIX_W), CONV_W ** -0.5),
        'lru_conv_b': nrm(ks[13], (DEPTH, MIX_W), 0.01),
        'lru_wa': nrm(ks[14], (DEPTH, N_HEADS, HEAD_DIM, HEAD_DIM), HEAD_DIM ** -0.5),
        'lru_ba': nrm(ks[15], (DEPTH, MIX_W), 0.01),
        'lru_wx': nrm(ks[16], (DEPTH, N_HEADS, HEAD_DIM, HEAD_DIM), HEAD_DIM ** -0.5),
        'lru_bx': nrm(ks[17], (DEPTH, MIX_W), 0.01),
        'lru_lambda': jnp.log(sa) - jnp.log1p(-sa),
        'w_branch': nrm(ks[19], (DEPTH, N_BRANCH, MIX_W, D_MODEL), MIX_W ** -0.5),
        'w_out': nrm(ks[20], (DEPTH, D_MODEL, D_MODEL), D_MODEL ** -0.5),
        'w_ffn_in': nrm(ks[21], (DEPTH, D_MODEL, 2 * FFN_HIDDEN), D_MODEL ** -0.5),
        'w_ffn_out': nrm(ks[22], (DEPTH, FFN_HIDDEN, D_MODEL), FFN_HIDDEN ** -0.5),
    }


def reference(x, norm_mix_pre, norm_mix_post, norm_ffn_pre, norm_ffn_post, w_in,
              attn_rel_bias, hgrn_lb_logits, hgrn_norm_g, gmlp_norm_g, gmlp_ws, gmlp_bs,
              lru_conv_w, lru_conv_b, lru_wa, lru_ba, lru_wx, lru_bx, lru_lambda,
              w_branch, w_out, w_ffn_in, w_ffn_out):
    p = jax.nn.softmax(hgrn_lb_logits.astype(jnp.float32), axis=0)
    lbs = jnp.cumsum(p, axis=0) - p[0]
    for l in range(DEPTH):
        h = rms_norm(x, norm_mix_pre[l])
        y = hybrid_mixer(h, w_in[l], attn_rel_bias[l], lbs[l], hgrn_norm_g[l], gmlp_norm_g[l],
                         gmlp_ws[l], gmlp_bs[l], lru_conv_w[l], lru_conv_b[l], lru_wa[l],
                         lru_ba[l], lru_wx[l], lru_bx[l], lru_lambda[l], w_branch[l], w_out[l])
        x = x + rms_norm(y, norm_mix_post[l])
        h = rms_norm(x, norm_ffn_pre[l])
        x = x + rms_norm(swiglu(h, w_ffn_in[l], w_ffn_out[l]), norm_ffn_post[l])
    return x
```

```cpp
#include <hip/hip_runtime.h>
#include <hip/hip_cooperative_groups.h>
#include <cstdio>
namespace cg = cooperative_groups;

#ifndef PROBE_IT
#define PROBE_IT 0
#endif
#ifndef PROBE_REP
#define PROBE_REP 0
#endif
#ifndef MULTI_LAUNCH
#define MULTI_LAUNCH 0
#endif

#define LAS __attribute__((address_space(3)))
typedef unsigned short bf16_t;
typedef short bf16x8 __attribute__((ext_vector_type(8)));
typedef float f32x4 __attribute__((ext_vector_type(4)));
typedef unsigned u32x4 __attribute__((ext_vector_type(4)));
typedef unsigned u32x2 __attribute__((ext_vector_type(2)));

constexpr int D = 1024, SEQ = 2048, M = 16384, ZLD = 2816, FF = 2816;
constexpr size_t ZG_OFF = (size_t)M * ZLD;
constexpr float EPS = 1e-6f, LOG2E = 1.4426950408889634f;
constexpr int P_OFF = 147456;
constexpr int LDS_BYTES = P_OFF + 512;
constexpr int NPHASE = 29;

constexpr size_t SZ_WIN = (size_t)6912 * 1024 * 2, SZ_WBR = (size_t)4096 * 256 * 2, SZ_WOUT = (size_t)1024 * 1024 * 2, SZ_WF1 = (size_t)5632 * 1024 * 2, SZ_WF2 = (size_t)1024 * 2816 * 2;
constexpr size_t OFF_WIN = 0, OFF_WBR = OFF_WIN + 4 * SZ_WIN, OFF_WOUT = OFF_WBR + 4 * SZ_WBR, OFF_WF1 = OFF_WOUT + 4 * SZ_WOUT, OFF_WF2 = OFF_WF1 + 4 * SZ_WF1;
constexpr size_t OFF_Z = OFF_WF2 + 4 * SZ_WF2, SZ_Z = (size_t)M * 6912 * 2;
constexpr size_t OFF_Y = OFF_Z, OFF_ACT = OFF_Z + (size_t)M * D * 4;
constexpr size_t OFF_H = OFF_Z + SZ_Z, OFF_OUTS = OFF_H + (size_t)M * D * 2;
constexpr size_t OFF_GMW = OFF_OUTS + (size_t)M * D * 2;
constexpr size_t OFF_WAT = OFF_GMW + 524288, OFF_WXT = OFF_WAT + 131072, OFF_LBS = OFF_WXT + 131072, OFF_SPL = OFF_LBS + 4096;
constexpr size_t OFF_LCAR = OFF_SPL + 4096, OFF_HGS = OFF_LCAR + 262144, OFF_HGD = OFF_HGS + 8388608, OFF_BAR = OFF_HGD + 131072, OFF_XCNT = OFF_BAR + 16384, OFF_XSLOT = OFF_XCNT + 32768, WS_END = OFF_XSLOT + 524288;

#define PFIELDS(X) \
    X(const float*, x_in) X(const float*, n_mix_pre) X(const float*, n_mix_post) X(const float*, n_ffn_pre) X(const float*, n_ffn_post) X(const float*, w_in) \
    X(const float*, rel_bias) X(const float*, lb_logits) X(const float*, hg_norm_g) X(const float*, gm_norm_g) X(const float*, gm_ws) X(const float*, gm_bs) \
    X(const float*, conv_w) X(const float*, conv_b) X(const float*, wa) X(const float*, ba) X(const float*, wx) X(const float*, bx) X(const float*, lam) \
    X(const float*, w_branch) X(const float*, w_out) X(const float*, w_f1) X(const float*, w_f2) \
    X(float*, x) X(bf16_t*, wt_in) X(bf16_t*, wt_br) X(bf16_t*, wt_out) X(bf16_t*, wt_f1) X(bf16_t*, wt_f2) X(bf16_t*, z) X(bf16_t*, hbuf) X(bf16_t*, outs) X(bf16_t*, act) \
    X(bf16_t*, gmw) X(bf16_t*, waT) X(bf16_t*, wxT) X(float*, y) X(float*, lbs) X(float*, spl) X(float*, lru_carry) X(float*, hgS) X(float*, hgD) X(unsigned*, bar) X(unsigned*, xcnt) X(float*, xslot)
#define PDECL(T, n) T n;
struct Params { PFIELDS(PDECL) int ph_lo, ph_hi; };

__device__ __forceinline__ unsigned pk2(float lo, float hi) { unsigned r; asm("v_cvt_pk_bf16_f32 %0, %1, %2" : "=v"(r) : "v"(lo), "v"(hi)); return r; }
__device__ __forceinline__ unsigned pk2s(float lo, float hi) { unsigned r; asm("s_nop 0\n\tv_cvt_pk_bf16_f32 %0, %1, %2" : "=v"(r) : "v"(lo), "v"(hi)); return r; }
__device__ __forceinline__ bf16_t f2bf(float f) { return (bf16_t)(pk2(f, 0.f) & 0xffffu); }
__device__ __forceinline__ float bf2f(unsigned b) { return __uint_as_float(b << 16); }
__device__ __forceinline__ float bflo(unsigned w) { return __uint_as_float(w << 16); }
__device__ __forceinline__ float bfhi(unsigned w) { return __uint_as_float(w & 0xffff0000u); }
__device__ __forceinline__ float fexp2(float x) { return __builtin_amdgcn_exp2f(x); }
__device__ __forceinline__ float fexp(float x) { return __builtin_amdgcn_exp2f(x * LOG2E); }
__device__ __forceinline__ float frcp(float x) { return __builtin_amdgcn_rcpf(x); }
__device__ __forceinline__ float sigm(float x) { return frcp(1.f + fexp(-x)); }
__device__ __forceinline__ float silu(float x) { return x * sigm(x); }
__device__ __forceinline__ float gelu_t(float x) { return x * sigm(1.5957691216057308f * (x + 0.044715f * x * x * x)); }
__device__ __forceinline__ float wave_sum(float v) {
#pragma unroll
    for (int o = 32; o >= 1; o >>= 1) v += __shfl_xor(v, o);
    return v;
}
__device__ __forceinline__ bf16x8 as_bf8(u32x4 w) { return __builtin_bit_cast(bf16x8, w); }
__device__ __forceinline__ f32x4 mfma16(bf16x8 a, bf16x8 b, f32x4 c) { return __builtin_amdgcn_mfma_f32_16x16x32_bf16(a, b, c, 0, 0, 0); }
#define ZERO4 ((f32x4){0.f, 0.f, 0.f, 0.f})
__device__ __forceinline__ void lds_barrier() { asm volatile("s_waitcnt lgkmcnt(0)" ::: "memory"); __builtin_amdgcn_s_barrier(); asm volatile("" ::: "memory"); }
__device__ __forceinline__ int opaque_bid() { int t = blockIdx.x; asm volatile("" : "+s"(t)); return t; }
__device__ __forceinline__ int opaque_gd() { int t = gridDim.x; asm volatile("" : "+s"(t)); return t; }
__device__ __forceinline__ int opaque_tid() { int t = threadIdx.x; asm volatile("" : "+v"(t)); return t; }
__device__ __forceinline__ unsigned long long lds_u64(const LAS void* a) { const u32x2 v = *(const LAS u32x2*)a; const unsigned lo = __builtin_amdgcn_readfirstlane(v.x), hi = __builtin_amdgcn_readfirstlane(v.y); return ((unsigned long long)hi << 32) | lo; }
#define PFETCH(T, n) q.n = (T)(__attribute__((address_space(1))) void*)lds_u64(&lp->n);
__device__ __forceinline__ Params fetchP(const LAS Params* lp0) { unsigned la = (unsigned)(unsigned long long)lp0; asm volatile("" : "+v"(la)); const LAS Params* lp = (const LAS Params*)la; Params q; PFIELDS(PFETCH) q.ph_lo = 0; q.ph_hi = 0; return q; }

#define XB_TMO      128
#define XB_XCNT(j)  (256  + 64 * (j))
#define XB_XSUB(j)  (1280 + 64 * (j))
#define XB_XGEN(j)  (2304 + 64 * (j))
#define XB_TOP      3328
#define XB_TOPGEN   3392
#define XCD_BAR_WORDS 3456
#define XB_SPIN_CAP (1u << 22)
__device__ __forceinline__ unsigned xb_ld(unsigned* p)              { return __hip_atomic_load(p, __ATOMIC_RELAXED, __HIP_MEMORY_SCOPE_AGENT); }
__device__ __forceinline__ unsigned xb_add(unsigned* p, unsigned v) { return __hip_atomic_fetch_add(p, v, __ATOMIC_RELAXED, __HIP_MEMORY_SCOPE_AGENT); }
__device__ __forceinline__ unsigned xb_xcc_id() { return (unsigned)__builtin_amdgcn_s_getreg((3 << 11) | 20) & 0xFu; }
#define XB_SPIN(cond, bar) do { unsigned _sp = 0; while (cond) { __builtin_amdgcn_s_sleep(1); \
    if ((++_sp & 255u) == 0u) { if (xb_ld(&(bar)[XB_TMO])) break; if (_sp > XB_SPIN_CAP) { atomicAdd(&(bar)[XB_TMO], 1u); break; } } } } while (0)
__device__ __forceinline__ void xcd_barrier_complete(unsigned* bar, unsigned x, unsigned& nloc, unsigned& nx) {
    const unsigned G = gridDim.x;
    unsigned sum, cnt, mine, sp = 0u;
    for (;;) {
        sum = 0u; cnt = 0u; mine = 0u;
#pragma unroll
        for (unsigned j = 0; j < 16; ++j) { const unsigned c = xb_ld(&bar[XB_XCNT(j)]); sum += c; cnt += (c > 0u) ? 1u : 0u; mine = (j == x) ? c : mine; }
        if (sum == G) break;
        __builtin_amdgcn_s_sleep(1);
        if ((++sp & 255u) == 0u) { if (xb_ld(&bar[XB_TMO])) break; if (sp > XB_SPIN_CAP) { atomicAdd(&bar[XB_TMO], 1u); break; } }
    }
    nloc = mine > 0u ? mine : 1u; nx = cnt > 0u ? cnt : 1u;
}
__device__ __forceinline__ void xcd_barrier(unsigned* bar, volatile LAS unsigned* st) {
    asm volatile("s_waitcnt vmcnt(0)" ::: "memory");
    __syncthreads();
    if (threadIdx.x == 0) {
        const unsigned x = xb_xcc_id();
        __builtin_amdgcn_s_waitcnt(0);
        unsigned nloc = st[0], nx = st[1];
        if (nloc == 0u) { xcd_barrier_complete(bar, x, nloc, nx); st[0] = nloc; st[1] = nx; }
        const unsigned old = xb_add(&bar[XB_XSUB(x)], 1u);
        const unsigned gen = old / nloc;
        if (old + 1u == (gen + 1u) * nloc) {
            __builtin_amdgcn_fence(__ATOMIC_RELEASE, "agent");
            asm volatile("s_waitcnt vmcnt(0)" ::: "memory");
            const unsigned og = xb_add(&bar[XB_TOP], 1u);
            const unsigned tg = og / nx;
            if (og + 1u == (tg + 1u) * nx) xb_add(&bar[XB_TOPGEN], 1u);
            else XB_SPIN(xb_ld(&bar[XB_TOPGEN]) == tg, bar);
            __builtin_amdgcn_fence(__ATOMIC_ACQUIRE, "agent");
            xb_add(&bar[XB_XGEN(x)], 1u);
            asm volatile("s_waitcnt vmcnt(0)" ::: "memory");
        } else {
            XB_SPIN(xb_ld(&bar[XB_XGEN(x)]) == gen, bar);
            __builtin_amdgcn_fence(__ATOMIC_ACQUIRE, "agent");
            asm volatile("s_waitcnt vmcnt(0)" ::: "memory");
        }
    }
    __syncthreads();
}

namespace pg8 {
constexpr int BM = 256, BK = 64, HALF = 128, HTB = HALF * BK * 2, NXCD = 8, WGM = 4;
__device__ __forceinline__ int lds_byte(int r, int c) { const int st = (r >> 4) * 2 + (c >> 5), rr = r & 15, cc = c & 31, ob = rr * 64 + cc * 2; return st * 1024 + (ob ^ (((ob >> 9) & 1) << 5)); }
__device__ __forceinline__ void stage_rc(int b, int& R, int& C) { const int st = b / 1024, sb = b % 1024, swz = sb ^ (((sb >> 9) & 1) << 5); R = (st >> 1) * 16 + swz / 64; C = (st & 1) * 32 + (swz % 64) / 2; }
__device__ __forceinline__ int perm32(int rho) { const int n = rho >> 4, i = rho & 15; return 8 * (i >> 2) + 4 * n + (i & 3); }
struct Unit { int pm, pn; };
struct Gemm { const bf16_t* A; const bf16_t* Bt; int M, N, K; int ashift; size_t astride; };
struct StaticOrder {
    int nM, nN, nwg, G, c;
    __device__ void init(int M_, int N_, int G_, int c_) { nM = M_ / BM; nN = N_ / BM; nwg = nM * nN; G = G_; c = c_; }
    __device__ bool next(int i, Unit& u) const {
        const long L = (long)i * G + c; if (L >= nwg) return false;
        int wgid = (int)L; { const int q = nwg / NXCD, r = nwg % NXCD, xcd = wgid % NXCD, off = wgid / NXCD; wgid = (xcd < r ? xcd * (q + 1) : r * (q + 1) + (xcd - r) * q) + off; }
        const int nig = WGM * nN, gid = wgid / nig, fm = gid * WGM, gsz = (nM - fm) < WGM ? (nM - fm) : WGM;
        u.pm = fm + ((wgid % nig) % gsz); u.pn = (wgid % nig) / gsz; return true;
    }
};

struct EpiF32 {
    static constexpr bool PERM = false, AFTER_DRAIN = false;
    float* C; int ldc;
    __device__ __forceinline__ void operator()(const f32x4 (&acc)[2][2][4][2], const Unit& u, int wr, int wc, int fr, int fq) const {
        const int row0 = u.pm * BM + wr * 64 + fr, col0 = u.pn * BM + wc * 32 + 4 * fq;
#pragma unroll
        for (int ai = 0; ai < 2; ++ai)
#pragma unroll
            for (int m = 0; m < 4; ++m) { float* rowp = C + (size_t)(row0 + ai * HALF + m * 16) * ldc + col0;
#pragma unroll
                for (int bj = 0; bj < 2; ++bj)
#pragma unroll
                    for (int n = 0; n < 2; ++n) *(f32x4*)(rowp + bj * HALF + n * 16) = acc[ai][bj][m][n]; }
    }
};
struct EpiZ {
    static constexpr bool PERM = true, AFTER_DRAIN = false;
    bf16_t* O; int ldc;
    __device__ __forceinline__ void operator()(const f32x4 (&acc)[2][2][4][2], const Unit& u, int wr, int wc, int fr, int fq) const {
        const int row0 = u.pm * BM + wr * 64 + fr, col0 = u.pn * BM + wc * 32 + 8 * fq;
#pragma unroll
        for (int ai = 0; ai < 2; ++ai)
#pragma unroll
            for (int m = 0; m < 4; ++m) { bf16_t* rowp = O + (size_t)(row0 + ai * HALF + m * 16) * ldc + col0;
#pragma unroll
                for (int bj = 0; bj < 2; ++bj) { const f32x4 v0 = acc[ai][bj][m][0], v1 = acc[ai][bj][m][1];
                    u32x4 w; w.x = pk2(v0[0], v0[1]); w.y = pk2(v0[2], v0[3]); w.z = pk2(v1[0], v1[1]); w.w = pk2(v1[2], v1[3]);
                    *(u32x4*)(rowp + bj * HALF) = w; } }
    }
};
struct EpiZG {
    static constexpr bool PERM = true, AFTER_DRAIN = false;
    bf16_t* O; bf16_t* Gt;
    __device__ __forceinline__ void operator()(const f32x4 (&acc)[2][2][4][2], const Unit& u, int wr, int wc, int fr, int fq) const {
        if (u.pn < 11) {
            const int row0 = u.pm * BM + wr * 64 + fr, col0 = u.pn * BM + wc * 32 + 8 * fq;
#pragma unroll
            for (int ai = 0; ai < 2; ++ai)
#pragma unroll
                for (int m = 0; m < 4; ++m) { bf16_t* rowp = O + (size_t)(row0 + ai * HALF + m * 16) * ZLD + col0;
#pragma unroll
                    for (int bj = 0; bj < 2; ++bj) { const f32x4 v0 = acc[ai][bj][m][0], v1 = acc[ai][bj][m][1];
                        u32x4 w; w.x = pk2(v0[0], v0[1]); w.y = pk2(v0[2], v0[3]); w.z = pk2(v1[0], v1[1]); w.w = pk2(v1[2], v1[3]);
                        *(u32x4*)(rowp + bj * HALF) = w; } }
        } else {
            const int g = u.pn - 11, n = g >> 2, q = g & 3;
            bf16_t* blk = Gt + (((size_t)n * 64 + u.pm) * 8 + q * 2) * 32768 + (size_t)((wr * 4 * 4 + wc) * 64 + fq * 16 + fr) * 8;
#pragma unroll
            for (int ai = 0; ai < 2; ++ai)
#pragma unroll
                for (int m = 0; m < 4; ++m)
#pragma unroll
                    for (int bj = 0; bj < 2; ++bj) { const f32x4 v0 = acc[ai][bj][m][0], v1 = acc[ai][bj][m][1];
                        u32x4 w; w.x = pk2(v0[0], v0[1]); w.y = pk2(v0[2], v0[3]); w.z = pk2(v1[0], v1[1]); w.w = pk2(v1[2], v1[3]);
                        *(u32x4*)(blk + (size_t)bj * 32768 + (size_t)((ai * 8 + m) * 4) * 512) = w; }
        }
    }
};
struct EpiSwi {
    static constexpr bool PERM = true, AFTER_DRAIN = false;
    bf16_t* O; int ldc;
    __device__ __forceinline__ void operator()(const f32x4 (&acc)[2][2][4][2], const Unit& u, int wr, int wc, int fr, int fq) const {
        const int row0 = u.pm * BM + wr * 64 + fr, col0 = u.pn * HALF + wc * 32 + 8 * fq;
#pragma unroll
        for (int ai = 0; ai < 2; ++ai)
#pragma unroll
            for (int m = 0; m < 4; ++m) { bf16_t* rowp = O + (size_t)(row0 + ai * HALF + m * 16) * ldc + col0;
                const f32x4 g0 = acc[ai][0][m][0], g1 = acc[ai][0][m][1], u0 = acc[ai][1][m][0], u1 = acc[ai][1][m][1];
                u32x4 w; w.x = pk2(silu(g0[0]) * u0[0], silu(g0[1]) * u0[1]); w.y = pk2(silu(g0[2]) * u0[2], silu(g0[3]) * u0[3]);
                w.z = pk2(silu(g1[0]) * u1[0], silu(g1[1]) * u1[1]); w.w = pk2(silu(g1[2]) * u1[2], silu(g1[3]) * u1[3]);
                *(u32x4*)rowp = w; }
    }
};

struct RmsX { float* slots; unsigned* cnt; unsigned target; };
struct EpiRms {
    static constexpr bool PERM = true, AFTER_DRAIN = true;
    const float* xin; float* x; const float* g1; const float* g2; bf16_t* h; RmsX e1, e2; int lin_in, lin_out;
    __device__ __forceinline__ void stats(const f32x4 (&v)[2][2][4][2], const Unit& u, int wr, int wc, int fr, int fq, LAS unsigned char* lds, int wid, int lane, const RmsX& e) const {
        LAS float* P = (LAS float*)lds; LAS float* S = (LAS float*)(lds + 4096);
#pragma unroll
        for (int ai = 0; ai < 2; ++ai)
#pragma unroll
            for (int m = 0; m < 4; ++m) { float s = 0.f;
#pragma unroll
                for (int bj = 0; bj < 2; ++bj)
#pragma unroll
                    for (int n = 0; n < 2; ++n) { const f32x4 t = v[ai][bj][m][n]; s += (t[0] * t[0] + t[1] * t[1]) + (t[2] * t[2] + t[3] * t[3]); }
                s += __shfl_xor(s, 16); s += __shfl_xor(s, 32);
                if (fq == 0) P[(ai * HALF + wr * 64 + m * 16 + fr) * 4 + wc] = s; }
        asm volatile("s_waitcnt lgkmcnt(0)" ::: "memory"); __builtin_amdgcn_s_barrier(); asm volatile("" ::: "memory");
        const int row = wid * 32 + (lane & 31);
        if (lane < 32) { const float t = (P[row * 4] + P[row * 4 + 1]) + (P[row * 4 + 2] + P[row * 4 + 3]);
            __hip_atomic_store((unsigned*)(e.slots + ((size_t)(u.pm * BM + row) * 4 + u.pn)), __float_as_uint(t), __ATOMIC_RELAXED, __HIP_MEMORY_SCOPE_AGENT); }
        asm volatile("s_waitcnt vmcnt(0)" ::: "memory");
        if (lane == 0) __hip_atomic_fetch_add(e.cnt + 64 * u.pm, 1u, __ATOMIC_RELAXED, __HIP_MEMORY_SCOPE_AGENT);
        if (wid == 0) { unsigned sp = 0;
            while ((unsigned)__builtin_amdgcn_readfirstlane(__hip_atomic_load(e.cnt + 64 * u.pm, __ATOMIC_RELAXED, __HIP_MEMORY_SCOPE_AGENT)) < e.target) { __builtin_amdgcn_s_sleep(2); if (++sp > (1u << 22)) break; }
            __builtin_amdgcn_fence(__ATOMIC_ACQUIRE, "agent"); }
        asm volatile("s_waitcnt vmcnt(0) lgkmcnt(0)" ::: "memory"); __builtin_amdgcn_s_barrier(); asm volatile("" ::: "memory");
        if (lane < 32) { const unsigned* sl = (const unsigned*)(e.slots + (size_t)(u.pm * BM + row) * 4); float t = 0.f;
#pragma unroll
            for (int k = 0; k < 4; ++k) t += __uint_as_float(__hip_atomic_load(sl + k, __ATOMIC_RELAXED, __HIP_MEMORY_SCOPE_AGENT));
            S[row] = rsqrtf(t * (1.f / 1024.f) + EPS); }
        asm volatile("s_waitcnt lgkmcnt(0)" ::: "memory"); __builtin_amdgcn_s_barrier(); asm volatile("" ::: "memory");
    }
    __device__ __forceinline__ void fused(f32x4 (&acc)[2][2][4][2], const Unit& u, int wr, int wc, int fr, int fq, LAS unsigned char* lds, int wid, int lane) const {
        const LAS float* S = (const LAS float*)(lds + 4096);
        const int col0 = u.pn * BM + wc * 32 + 8 * fq;
        stats(acc, u, wr, wc, fr, fq, lds, wid, lane, e1);
        const bool defer = lin_in && !lin_out;
#pragma unroll
        for (int ai = 0; ai < 2; ++ai)
#pragma unroll
            for (int m = 0; m < 4; ++m) { const int r = ai * HALF + wr * 64 + m * 16 + fr; const float rs = S[r]; const int rb = ai * 8 + wr * 4 + m;
#pragma unroll
                for (int bj = 0; bj < 2; ++bj)
#pragma unroll
                    for (int n = 0; n < 2; ++n) { const size_t orm = (size_t)(u.pm * BM + r) * D + col0 + bj * HALF + n * 4, oln = (size_t)(u.pm * BM + rb * 16 + 8 * bj + 2 * wc + n) * D + u.pn * BM + lane * 4;
                        const f32x4 xv = *(const f32x4*)(xin + (lin_in ? oln : orm)); const f32x4 gv = *(const f32x4*)(g1 + col0 + bj * HALF + n * 4);
                        const f32x4 o = xv + acc[ai][bj][m][n] * rs * gv; acc[ai][bj][m][n] = o; if (!defer) *(f32x4*)(x + (lin_out ? oln : orm)) = o; }
                asm volatile("" : "+v"(acc[ai][0][m][0]), "+v"(acc[ai][0][m][1]), "+v"(acc[ai][1][m][0]), "+v"(acc[ai][1][m][1]));
                asm volatile("" ::: "memory"); }
        if (defer) {
            asm volatile("s_waitcnt vmcnt(0)" ::: "memory"); __builtin_amdgcn_s_barrier(); asm volatile("" ::: "memory");
#pragma unroll
            for (int ai = 0; ai < 2; ++ai)
#pragma unroll
                for (int m = 0; m < 4; ++m) { const int r = ai * HALF + wr * 64 + m * 16 + fr; float* xp = x + (size_t)(u.pm * BM + r) * D + col0;
#pragma unroll
                    for (int bj = 0; bj < 2; ++bj)
#pragma unroll
                        for (int n = 0; n < 2; ++n) *(f32x4*)(xp + bj * HALF + n * 4) = acc[ai][bj][m][n]; }
        }
        if (h) {
            stats(acc, u, wr, wc, fr, fq, lds, wid, lane, e2);
#pragma unroll
            for (int ai = 0; ai < 2; ++ai)
#pragma unroll
                for (int m = 0; m < 4; ++m) { const int r = ai * HALF + wr * 64 + m * 16 + fr; const float rs = S[r]; bf16_t* hp = h + (size_t)(u.pm * BM + r) * D + col0;
#pragma unroll
                    for (int bj = 0; bj < 2; ++bj) { const f32x4 ga = *(const f32x4*)(g2 + col0 + bj * HALF), gb = *(const f32x4*)(g2 + col0 + bj * HALF + 4);
                        const f32x4 oa = acc[ai][bj][m][0] * rs * ga, ob = acc[ai][bj][m][1] * rs * gb;
                        u32x4 w; w.x = pk2(oa[0], oa[1]); w.y = pk2(oa[2], oa[3]); w.z = pk2(ob[0], ob[1]); w.w = pk2(ob[2], ob[3]); *(u32x4*)(hp + bj * HALF) = w; }
                    asm volatile("" ::: "memory"); }
        }
    }
};

template <class Epi>
__device__ __forceinline__ void gemm_phase(LAS unsigned char* lds, const Gemm g, const int G, const int cidx, const Epi& E) {
    const int tid = opaque_tid(), wid = __builtin_amdgcn_readfirstlane(tid >> 6), lane = tid & 63, wr = wid >> 2, wc = wid & 3, fr = lane & 15, fq = lane >> 4;
    const int K = g.K, nt = K / BK;
    StaticOrder S; S.init(g.M, g.N, G, cidx);
    unsigned voffA[2], voffB[2];
#pragma unroll
    for (int i = 0; i < 2; ++i) { int R, C; stage_rc(tid * 16 + i * 8192, R, C); const int Rb = Epi::PERM ? ((R & ~31) + perm32(R & 31)) : R;
        voffA[i] = (unsigned)(R * K + C) * 2u; voffB[i] = (unsigned)(Rb * K + C) * 2u; }
    const size_t kstep = (size_t)(BK * 2);
    const size_t hstep = (size_t)HALF * K * 2;
    const size_t tstep = 2 * hstep;
    const unsigned ldsw = (unsigned)wid * 1024u;
    const int aoff = lds_byte(wr * 64 + fr, fq * 8), boff = lds_byte(wc * 32 + fr, fq * 8);
#define PG8_SA(b, h) (((b) * 2 + (h)) * HTB)
#define PG8_SB(b, h) ((4 + (b) * 2 + (h)) * HTB)
#define PG8_STAGE(bufoff, gbase, voff) do { _Pragma("unroll") for (int _i = 0; _i < 2; ++_i) \
        __builtin_amdgcn_global_load_lds((const unsigned*)((const char*)(gbase) + (voff)[_i]), (LAS unsigned*)(lds + (bufoff) + ldsw + _i * 8192), 16, 0, 0); } while (0)
#define PG8_LDA(dst, b, h) do { _Pragma("unroll") for (int m = 0; m < 4; ++m) _Pragma("unroll") for (int k = 0; k < 2; ++k) dst[m][k] = *(const LAS bf16x8*)(lds + PG8_SA(b, h) + aoff + m * 2048 + k * 1024); } while (0)
#define PG8_LDB(dst, b, h) do { _Pragma("unroll") for (int n = 0; n < 2; ++n) _Pragma("unroll") for (int k = 0; k < 2; ++k) dst[n][k] = *(const LAS bf16x8*)(lds + PG8_SB(b, h) + boff + n * 2048 + k * 1024); } while (0)
#define PG8_MMA(ai, bj, At, Bt) do { __builtin_amdgcn_s_setprio(1); _Pragma("unroll") for (int m = 0; m < 4; ++m) _Pragma("unroll") for (int n = 0; n < 2; ++n) _Pragma("unroll") for (int k = 0; k < 2; ++k) \
        acc[ai][bj][m][n] = __builtin_amdgcn_mfma_f32_16x16x32_bf16(Bt[n][k], At[m][k], acc[ai][bj][m][n], 0, 0, 0); __builtin_amdgcn_s_setprio(0); } while (0)
#define PG8_WAIT_V(n) asm volatile("s_waitcnt vmcnt(" #n ")" ::: "memory")
#define PG8_WAIT_L(n) asm volatile("s_waitcnt lgkmcnt(" #n ")" ::: "memory")
#define PG8_BAR __builtin_amdgcn_s_barrier()
#define PG8_SCHED __builtin_amdgcn_sched_barrier(0)
#define PG8_ABASE(u) ((const char*)g.A + (size_t)((u).pn >> g.ashift) * g.astride + (size_t)(u).pm * tstep)
    Unit cur, nxt; int ui = 0;
    if (!S.next(0, cur)) return;
    f32x4 acc[2][2][4][2];
#pragma unroll
    for (int a = 0; a < 2; ++a)
#pragma unroll
        for (int b = 0; b < 2; ++b)
#pragma unroll
            for (int m = 0; m < 4; ++m)
#pragma unroll
                for (int n = 0; n < 2; ++n) acc[a][b][m][n] = ZERO4;
    bf16x8 At[4][2], B0[2][2], B1[2][2];
    const char* cA = PG8_ABASE(cur); const char* cB = (const char*)g.Bt + (size_t)cur.pn * tstep;
    PG8_STAGE(PG8_SB(0, 0), cB, voffB); PG8_STAGE(PG8_SB(0, 1), cB + hstep, voffB); PG8_STAGE(PG8_SA(0, 0), cA, voffA); PG8_STAGE(PG8_SA(0, 1), cA + hstep, voffA);
    if (wr == 1) PG8_BAR;
    PG8_WAIT_V(2); PG8_BAR;
    PG8_STAGE(PG8_SB(1, 0), cB + kstep, voffB); PG8_STAGE(PG8_SA(1, 0), cA + kstep, voffA); PG8_STAGE(PG8_SB(1, 1), cB + hstep + kstep, voffB);
    PG8_WAIT_V(6); PG8_BAR;
    for (;;) {
        const bool has_next = S.next(ui + 1, nxt);
        const char* nA = has_next ? PG8_ABASE(nxt) : cA; const char* nB = has_next ? (const char*)g.Bt + (size_t)nxt.pn * tstep : cB;
        for (int t = 0; t < nt; t += 2) {
            const bool last = (t == nt - 2);
            const char* a1 = cA + (size_t)(t + 1) * kstep;
            const char* a2 = last ? nA : cA + (size_t)(t + 2) * kstep; const char* b2 = last ? nB : cB + (size_t)(t + 2) * kstep;
            const char* a3 = a2 + kstep; const char* b3 = b2 + kstep;
            PG8_LDB(B0, 0, 0); PG8_LDB(B1, 0, 1); PG8_SCHED; PG8_LDA(At, 0, 0); PG8_STAGE(PG8_SA(1, 1), a1 + hstep, voffA);
            PG8_WAIT_V(8); PG8_WAIT_L(0); PG8_BAR; PG8_MMA(0, 0, At, B0); PG8_MMA(0, 1, At, B1); PG8_BAR; PG8_SCHED;
            PG8_LDA(At, 0, 1); PG8_STAGE(PG8_SB(0, 0), b2, voffB); PG8_STAGE(PG8_SB(0, 1), b2 + hstep, voffB); PG8_STAGE(PG8_SA(0, 0), a2, voffA);
            PG8_WAIT_V(8); PG8_WAIT_L(0); PG8_BAR; PG8_MMA(1, 0, At, B0); PG8_MMA(1, 1, At, B1); PG8_BAR; PG8_SCHED;
            PG8_LDB(B0, 1, 0); PG8_LDB(B1, 1, 1); PG8_SCHED; PG8_LDA(At, 1, 0); PG8_STAGE(PG8_SA(0, 1), a2 + hstep, voffA);
            PG8_WAIT_V(8); PG8_WAIT_L(0); PG8_BAR; PG8_MMA(0, 0, At, B0); PG8_MMA(0, 1, At, B1); PG8_BAR; PG8_SCHED;
            PG8_LDA(At, 1, 1); PG8_STAGE(PG8_SB(1, 0), b3, voffB); PG8_STAGE(PG8_SB(1, 1), b3 + hstep, voffB); PG8_STAGE(PG8_SA(1, 0), a3, voffA);
            PG8_WAIT_V(8); PG8_WAIT_L(0); PG8_BAR; PG8_MMA(1, 0, At, B0); PG8_MMA(1, 1, At, B1); PG8_BAR; PG8_SCHED;
        }
        if constexpr (!Epi::AFTER_DRAIN) E(acc, cur, wr, wc, fr, fq);
        if (!has_next) break;
#pragma unroll
        for (int a = 0; a < 2; ++a)
#pragma unroll
            for (int b = 0; b < 2; ++b)
#pragma unroll
                for (int m = 0; m < 4; ++m)
#pragma unroll
                    for (int n = 0; n < 2; ++n) acc[a][b][m][n] = ZERO4;
        cur = nxt; cA = nA; cB = nB; ++ui;
    }
    PG8_WAIT_V(0);
    if (wr == 0) PG8_BAR;
    PG8_BAR;
    if constexpr (Epi::AFTER_DRAIN) E.fused(acc, cur, wr, wc, fr, fq, lds, wid, lane);
#undef PG8_SA
#undef PG8_SB
#undef PG8_STAGE
#undef PG8_LDA
#undef PG8_LDB
#undef PG8_MMA
#undef PG8_WAIT_V
#undef PG8_WAIT_L
#undef PG8_BAR
#undef PG8_SCHED
#undef PG8_ABASE
}
}

struct TDesc { const float* src; bf16_t* dst; int ld_src, ld_dst; };
__device__ __forceinline__ TDesc tile_desc(const Params& p, int i) {
    TDesc d; const int l = i / 4352; int r = i - l * 4352;
    if (r < 1728) { const int kt = r / 108, nt = r - kt * 108;
        d.src = p.w_in + (size_t)l * 1024 * 6912 + (size_t)(kt * 64) * 6912 + nt * 64; d.ld_src = 6912; d.dst = p.wt_in + (size_t)l * 6912 * 1024 + (size_t)(nt * 64) * 1024 + kt * 64; d.ld_dst = 1024; return d; }
    r -= 1728;
    if (r < 256) { const int n = r >> 6, rr = r & 63, kt = rr >> 4, nt = rr & 15;
        d.src = p.w_branch + ((size_t)l * 4 + n) * 256 * 1024 + (size_t)(kt * 64) * 1024 + nt * 64; d.ld_src = 1024; d.dst = p.wt_br + (size_t)l * 4096 * 256 + (size_t)(n * 1024 + nt * 64) * 256 + kt * 64; d.ld_dst = 256; return d; }
    r -= 256;
    if (r < 256) { const int kt = r >> 4, nt = r & 15;
        d.src = p.w_out + (size_t)l * 1024 * 1024 + (size_t)(kt * 64) * 1024 + nt * 64; d.ld_src = 1024; d.dst = p.wt_out + (size_t)l * 1024 * 1024 + (size_t)(nt * 64) * 1024 + kt * 64; d.ld_dst = 1024; return d; }
    r -= 256;
    if (r < 1408) { const int kt = r / 88, nt = r - kt * 88; const int n0 = nt * 64, bj = n0 / 2816, rem = n0 - bj * 2816, pn = rem >> 7, r0 = rem & 127;
        d.src = p.w_f1 + (size_t)l * 1024 * 5632 + (size_t)(kt * 64) * 5632 + n0; d.ld_src = 5632; d.dst = p.wt_f1 + (size_t)l * 5632 * 1024 + (size_t)(256 * pn + 128 * bj + r0) * 1024 + kt * 64; d.ld_dst = 1024; return d; }
    r -= 1408;
    { const int kt = r >> 4, nt = r & 15;
        d.src = p.w_f2 + (size_t)l * 2816 * 1024 + (size_t)(kt * 64) * 1024 + nt * 64; d.ld_src = 1024; d.dst = p.wt_f2 + (size_t)l * 1024 * 2816 + (size_t)(nt * 64) * 2816 + kt * 64; d.ld_dst = 2816; return d; }
}
__device__ __forceinline__ void norm_phase(const float* y, const float* gy, const float* xin, float* xo, const float* gn, bf16_t* h) {
    const int tid = opaque_tid(), wid = tid >> 6, lane = tid & 63;
    for (int row = opaque_bid() * 8 + wid; row < M; row += opaque_gd() * 8) {
        f32x4 xv[4]; const float* xr = xin + (size_t)row * D + lane * 4;
#pragma unroll
        for (int i = 0; i < 4; ++i) xv[i] = *(const f32x4*)(xr + i * 256);
        if (y) {
            f32x4 yv[4]; const bf16_t* yr = (const bf16_t*)y + (size_t)row * D + lane * 4; float ss = 0.f;
#pragma unroll
            for (int i = 0; i < 4; ++i) { const u32x2 yw = *(const u32x2*)(yr + i * 256); yv[i] = (f32x4){bflo(yw.x), bfhi(yw.x), bflo(yw.y), bfhi(yw.y)}; ss += yv[i][0] * yv[i][0] + yv[i][1] * yv[i][1] + yv[i][2] * yv[i][2] + yv[i][3] * yv[i][3]; }
            ss = wave_sum(ss); const float rs = rsqrtf(ss * (1.f / 1024.f) + EPS);
#pragma unroll
            for (int i = 0; i < 4; ++i) { const f32x4 gv = *(const f32x4*)(gy + lane * 4 + i * 256); xv[i] += yv[i] * rs * gv; }
        }
        if (xo) {
#pragma unroll
            for (int i = 0; i < 4; ++i) *(f32x4*)(xo + (size_t)row * D + lane * 4 + i * 256) = xv[i];
        }
        if (h) {
            float ss = 0.f;
#pragma unroll
            for (int i = 0; i < 4; ++i) ss += xv[i][0] * xv[i][0] + xv[i][1] * xv[i][1] + xv[i][2] * xv[i][2] + xv[i][3] * xv[i][3];
            ss = wave_sum(ss); const float rs = rsqrtf(ss * (1.f / 1024.f) + EPS);
#pragma unroll
            for (int i = 0; i < 4; ++i) { const f32x4 gv = *(const f32x4*)(gn + lane * 4 + i * 256); const f32x4 o = xv[i] * rs * gv;
                u32x2 w; w.x = pk2(o[0], o[1]); w.y = pk2(o[2], o[3]); *(u32x2*)(h + (size_t)row * D + lane * 4 + i * 256) = w; }
        }
    }
}

__device__ __forceinline__ void conv_range(const Params& p, LAS unsigned char* lds, int t0, int t1, int rank, int nranks) {
    LAS float* tile = (LAS float*)lds;
    const int tid = opaque_tid(); const int r = tid >> 4, c4 = (tid & 15) * 4, n = tid >> 3, k8 = (tid & 7) * 8;
    int i = t0 + rank; f32x4 v0 = ZERO4, v1 = ZERO4;
    if (i < t1) { const TDesc d = tile_desc(p, i); v0 = *(const f32x4*)(d.src + (size_t)r * d.ld_src + c4); v1 = *(const f32x4*)(d.src + (size_t)(r + 32) * d.ld_src + c4); }
    for (; i < t1; i += nranks) {
        const TDesc d = tile_desc(p, i);
        lds_barrier();
        { LAS float* tp = tile + r * 65 + c4; tp[0] = v0[0]; tp[1] = v0[1]; tp[2] = v0[2]; tp[3] = v0[3]; tp += 32 * 65; tp[0] = v1[0]; tp[1] = v1[1]; tp[2] = v1[2]; tp[3] = v1[3]; }
        if (i + nranks < t1) { const TDesc dn = tile_desc(p, i + nranks); v0 = *(const f32x4*)(dn.src + (size_t)r * dn.ld_src + c4); v1 = *(const f32x4*)(dn.src + (size_t)(r + 32) * dn.ld_src + c4); }
        lds_barrier();
        float v[8];
#pragma unroll
        for (int q = 0; q < 8; ++q) v[q] = tile[(k8 + q) * 65 + n];
        u32x4 w; w.x = pk2(v[0], v[1]); w.y = pk2(v[2], v[3]); w.z = pk2(v[4], v[5]); w.w = pk2(v[6], v[7]);
        *(u32x4*)(d.dst + (size_t)n * d.ld_dst + k8) = w;
    }
    lds_barrier();
}

__device__ __forceinline__ void phase0(const Params& p, LAS unsigned char* lds) {
    conv_range(p, lds, 0, 4352, opaque_bid(), opaque_gd());
    const int gt = opaque_bid() * 512 + opaque_tid(), nth = opaque_gd() * 512;
    for (int i = gt; i < 262144; i += nth) { const int q = i & 127, pp = (i >> 7) & 127; p.gmw[i] = (q <= pp) ? f2bf(p.gm_ws[i]) : (bf16_t)0; }
    for (int i = gt; i < 65536; i += nth) { const int ii = i & 63, j = (i >> 6) & 63, lh = i >> 12; p.waT[i] = f2bf(p.wa[(lh * 64 + ii) * 64 + j]); p.wxT[i] = f2bf(p.wx[(lh * 64 + ii) * 64 + j]); }
    for (int i = gt; i < 1024; i += nth) p.spl[i] = log1pf(expf(-p.lam[i]));
    for (int i = gt; i < 256; i += nth) {
        const float a0 = p.lb_logits[i], a1 = p.lb_logits[256 + i], a2 = p.lb_logits[512 + i], a3 = p.lb_logits[768 + i];
        const float mx = fmaxf(fmaxf(a0, a1), fmaxf(a2, a3)); const float e0 = expf(a0 - mx), e1 = expf(a1 - mx), e2 = expf(a2 - mx), e3 = expf(a3 - mx);
        const float inv = 1.f / (e0 + e1 + e2 + e3);
        p.lbs[i] = 0.f; p.lbs[256 + i] = e1 * inv; p.lbs[512 + i] = (e1 + e2) * inv; p.lbs[768 + i] = (e1 + e2 + e3) * inv;
    }
    norm_phase(nullptr, nullptr, p.x_in, nullptr, p.n_mix_pre, p.hbuf);
}

typedef short v4i16_t __attribute__((ext_vector_type(4)));
__device__ __forceinline__ void attn_item(const Params& p, int l, int item, LAS unsigned char* lds) {
    const int tid = opaque_tid(), wid = tid >> 6, lane = tid & 63, fr = lane & 15, fq = lane >> 4;
    const int b = item >> 6, c = (item >> 1) & 31, hp = item & 1;
    const int hh = wid >> 2, head = hp * 2 + hh, q0 = (wid & 3) * 16;
    constexpr int KST = 272, VST = 288, KBUF = 64 * KST, BUFB = KBUF + 64 * VST;
    LAS float* bias_s = (LAS float*)(lds + 2 * BUFB);
    const bf16_t* zb = p.z + (size_t)b * SEQ * ZLD;
    lds_barrier();
    for (int i = tid; i < 640; i += 512) { const int h2 = i / 320, idx = i - h2 * 320; bias_s[i] = p.rel_bias[((size_t)l * 4 + hp * 2 + h2) * 320 + idx] * LOG2E; }
    const bf16_t* qp = zb + (size_t)(c * 64 + q0 + fr) * ZLD + head * 64 + fq * 8;
    const bf16x8 qf0 = *(const bf16x8*)qp, qf1 = *(const bf16x8*)(qp + 32);
    f32x4 o[4];
#pragma unroll
    for (int dt = 0; dt < 4; ++dt) o[dt] = ZERO4;
    float mrun = -1e30f, lsum = 0.f;
    const int jj0 = c >= 8 ? 0 : 8 - c;
    const int skey = tid >> 4, spc = tid & 15;
    u32x4 kr[2], vr[2];
#define ATT_LOAD(jj_) do { const bf16_t* kb_ = zb + (size_t)((c - 8 + (jj_)) * 64 + skey) * ZLD + hp * 128 + spc * 8; \
        kr[0] = *(const u32x4*)(kb_ + 256); vr[0] = *(const u32x4*)(kb_ + 512); kr[1] = *(const u32x4*)(kb_ + (size_t)32 * ZLD + 256); vr[1] = *(const u32x4*)(kb_ + (size_t)32 * ZLD + 512); } while (0)
    ATT_LOAD(jj0);
    for (int jj = jj0; jj <= 8; ++jj) {
        LAS unsigned char* Kb = lds + (jj & 1) * BUFB; LAS unsigned char* Vb = Kb + KBUF;
        *(LAS u32x4*)(Kb + skey * KST + spc * 16) = kr[0]; *(LAS u32x4*)(Kb + (skey + 32) * KST + spc * 16) = kr[1];
        *(LAS u32x4*)(Vb + skey * VST + spc * 16) = vr[0]; *(LAS u32x4*)(Vb + (skey + 32) * VST + spc * 16) = vr[1];
        if (jj < 8) ATT_LOAD(jj + 1);
        lds_barrier();
        f32x4 s[4];
#pragma unroll
        for (int kt = 0; kt < 4; ++kt) { const LAS unsigned char* kp = Kb + (kt * 16 + fr) * KST + hh * 128 + fq * 16;
            s[kt] = mfma16(*(const LAS bf16x8*)kp, qf0, ZERO4); s[kt] = mfma16(*(const LAS bf16x8*)(kp + 64), qf1, s[kt]); }
        const int base = (8 - jj) * 64 + q0 + fr;
        float cmax = -1e30f;
#pragma unroll
        for (int kt = 0; kt < 4; ++kt)
#pragma unroll
            for (int j = 0; j < 4; ++j) { const int dist = base - (kt * 16 + fq * 4 + j); const int idx = (dist < 256 ? dist : 256) + 63;
                const float sv = s[kt][j] * (0.125f * LOG2E) + bias_s[hh * 320 + idx]; s[kt][j] = sv; cmax = fmaxf(cmax, sv); }
        cmax = fmaxf(cmax, __shfl_xor(cmax, 16)); cmax = fmaxf(cmax, __shfl_xor(cmax, 32));
        const float mnew = fmaxf(mrun, cmax), alpha = fexp2(mrun - mnew); mrun = mnew;
        float ps = 0.f;
#pragma unroll
        for (int kt = 0; kt < 4; ++kt)
#pragma unroll
            for (int j = 0; j < 4; ++j) { const float e = fexp2(s[kt][j] - mnew); s[kt][j] = e; ps += e; }
        lsum = lsum * alpha + ps;
#pragma unroll
        for (int dt = 0; dt < 4; ++dt) o[dt] *= alpha;
#pragma unroll
        for (int i = 0; i < 2; ++i) {
            u32x4 pw; pw.x = pk2s(s[2 * i][0], s[2 * i][1]); pw.y = pk2s(s[2 * i][2], s[2 * i][3]); pw.z = pk2s(s[2 * i + 1][0], s[2 * i + 1][1]); pw.w = pk2s(s[2 * i + 1][2], s[2 * i + 1][3]);
            const bf16x8 pb = as_bf8(pw);
            const LAS unsigned char* vp = Vb + (32 * i + 4 * fq + (fr >> 2)) * VST + hh * 128 + (fr & 3) * 8;
#pragma unroll
            for (int dt = 0; dt < 4; ++dt) {
                const v4i16_t a0 = __builtin_amdgcn_ds_read_tr16_b64_v4i16((LAS v4i16_t*)(vp + dt * 32));
                const v4i16_t a1 = __builtin_amdgcn_ds_read_tr16_b64_v4i16((LAS v4i16_t*)(vp + 16 * VST + dt * 32));
                const bf16x8 av = __builtin_shufflevector(a0, a1, 0, 1, 2, 3, 4, 5, 6, 7);
                o[dt] = mfma16(av, pb, o[dt]); }
        }
    }
#undef ATT_LOAD
    lsum += __shfl_xor(lsum, 16); lsum += __shfl_xor(lsum, 32);
    const float inv = 1.f / lsum;
    bf16_t* op = p.outs + ((size_t)b * SEQ + c * 64 + q0 + fr) * 256 + head * 64 + fq * 4;
#pragma unroll
    for (int dt = 0; dt < 4; ++dt) { u32x2 w; w.x = pk2(o[dt][0] * inv, o[dt][1] * inv); w.y = pk2(o[dt][2] * inv, o[dt][3] * inv); *(u32x2*)(op + dt * 16) = w; }
}

__device__ __forceinline__ void gmlp_item(const Params& p, int l, int item, LAS unsigned char* lds) {
    const int tid = opaque_tid(), wid = tid >> 6, lane = tid & 63, fr = lane & 15, fq = lane >> 4;
    const int b = item >> 6, blk = (item >> 2) & 15, g = item & 3;
    LAS bf16_t* vnT = (LAS bf16_t*)lds;
    const size_t T0 = (size_t)b * SEQ + blk * 128;
    lds_barrier();
    const int nks = (wid >> 1) + 1;
    const size_t Tw = T0 + wid * 16 + fr;
    bf16x8 bwp[4]; u32x2 uwp[4];
    { const bf16_t* wp = p.gmw + (((size_t)l * 4 + g) * 128 + wid * 16 + fr) * 128 + fq * 8;
#pragma unroll
      for (int ks = 0; ks < 4; ++ks) bwp[ks] = *(const bf16x8*)(wp + (ks < nks ? ks : 0) * 32);
#pragma unroll
      for (int ct = 0; ct < 4; ++ct) uwp[ct] = *(const u32x2*)(p.z + Tw * ZLD + 1792 + g * 64 + ct * 16 + fq * 4); }
    const float bsv = p.gm_bs[((size_t)l * 4 + g) * 128 + wid * 16 + fr];
    { const int pp = tid >> 2, qd = tid & 3; const bf16_t* vp = p.z + (T0 + pp) * ZLD + 2048 + qd * 16;
      float keep[16]; float ss = 0.f;
#pragma unroll
      for (int i = 0; i < 16; ++i) keep[i] = 0.f;
#pragma unroll
      for (int gg = 0; gg < 4; ++gg) { const u32x4 w0 = *(const u32x4*)(vp + gg * 64), w1 = *(const u32x4*)(vp + gg * 64 + 8);
          const float v[16] = {bflo(w0.x), bfhi(w0.x), bflo(w0.y), bfhi(w0.y), bflo(w0.z), bfhi(w0.z), bflo(w0.w), bfhi(w0.w),
                               bflo(w1.x), bfhi(w1.x), bflo(w1.y), bfhi(w1.y), bflo(w1.z), bfhi(w1.z), bflo(w1.w), bfhi(w1.w)};
#pragma unroll
          for (int i = 0; i < 16; ++i) { const float ge = gelu_t(v[i]); ss += ge * ge; keep[i] = (gg == g) ? ge : keep[i]; } }
      ss += __shfl_xor(ss, 1); ss += __shfl_xor(ss, 2);
      const float rstd = rsqrtf(ss * (1.f / 256.f) + EPS);
      const float* ng = p.gm_norm_g + l * 256 + g * 64 + qd * 16;
#pragma unroll
      for (int i = 0; i < 16; ++i) vnT[(qd * 16 + i) * 136 + pp] = f2bf(keep[i] * rstd * ng[i]);
    }
    lds_barrier();
    { f32x4 acc[4];
#pragma unroll
      for (int ct = 0; ct < 4; ++ct) acc[ct] = ZERO4;
#pragma unroll
      for (int ks = 0; ks < 4; ++ks) if (ks < nks) {
#pragma unroll
          for (int ct = 0; ct < 4; ++ct) { const bf16x8 av = *(const LAS bf16x8*)(vnT + (ct * 16 + fr) * 136 + ks * 32 + fq * 8); acc[ct] = mfma16(av, bwp[ks], acc[ct]); } }
#pragma unroll
      for (int ct = 0; ct < 4; ++ct) { const u32x2 uw = uwp[ct];
          u32x2 w; w.x = pk2(gelu_t(bflo(uw.x)) * (acc[ct][0] + bsv), gelu_t(bfhi(uw.x)) * (acc[ct][1] + bsv));
          w.y = pk2(gelu_t(bflo(uw.y)) * (acc[ct][2] + bsv), gelu_t(bfhi(uw.y)) * (acc[ct][3] + bsv));
          *(u32x2*)(p.outs + ((size_t)2 * M + Tw) * 256 + g * 64 + ct * 16 + fq * 4) = w; }
    }
}

__device__ __forceinline__ void lru_item(const Params& p, int l, int item, LAS unsigned char* lds) {
    const int tid = opaque_tid(), wid = tid >> 6, lane = tid & 63, fr = lane & 15, fq = lane >> 4;
    const int b = item >> 6, h = (item >> 4) & 3, seg = item & 15;
    LAS unsigned char* wb = lds + wid * 10752;
    LAS bf16_t* xa = (LAS bf16_t*)wb; LAS float* xf = (LAS float*)(wb + 2304); LAS float* sa = (LAS float*)(wb + 6528);
    LAS float* ct = (LAS float*)(lds + 86016);
    const int t0 = seg * 128 + wid * 16; const size_t Tb = (size_t)b * SEQ;
    const int ch = h * 64 + lane;
    lds_barrier();
    unsigned xr[19];
#pragma unroll
    for (int i = 0; i < 19; ++i) { const int t = t0 - 3 + i; xr[i] = (t >= 0) ? (unsigned)p.z[(Tb + (t >= 0 ? t : 0)) * ZLD + 2304 + ch] : 0u; }
    bf16x8 wa0[4], wa1[4], wx0[4], wx1[4];
    { const bf16_t* wap = p.waT + (((size_t)l * 4 + h) * 64 + fr) * 64 + fq * 8; const bf16_t* wxp = p.wxT + (((size_t)l * 4 + h) * 64 + fr) * 64 + fq * 8;
#pragma unroll
      for (int jt = 0; jt < 4; ++jt) { wa0[jt] = *(const bf16x8*)(wap + jt * 1024); wa1[jt] = *(const bf16x8*)(wap + jt * 1024 + 32); wx0[jt] = *(const bf16x8*)(wxp + jt * 1024); wx1[jt] = *(const bf16x8*)(wxp + jt * 1024 + 32); } }
    { const float cb = p.conv_b[l * 256 + ch], cw0 = p.conv_w[(l * 4 + 0) * 256 + ch], cw1 = p.conv_w[(l * 4 + 1) * 256 + ch], cw2 = p.conv_w[(l * 4 + 2) * 256 + ch], cw3 = p.conv_w[(l * 4 + 3) * 256 + ch];
#pragma unroll
      for (int i = 0; i < 16; ++i) { const float xc = cb + bf2f(xr[i]) * cw0 + bf2f(xr[i + 1]) * cw1 + bf2f(xr[i + 2]) * cw2 + bf2f(xr[i + 3]) * cw3; xa[i * 72 + lane] = f2bf(xc); xf[i * 66 + lane] = xc; } }
    lds_barrier();
    { const bf16x8 a0 = *(const LAS bf16x8*)(xa + fr * 72 + fq * 8), a1 = *(const LAS bf16x8*)(xa + fr * 72 + 32 + fq * 8);
#pragma unroll
      for (int jt = 0; jt < 4; ++jt) {
          f32x4 pa = mfma16(a0, wa0[jt], ZERO4); pa = mfma16(a1, wa1[jt], pa);
          f32x4 px = mfma16(a0, wx0[jt], ZERO4); px = mfma16(a1, wx1[jt], px);
          const int cj = l * 256 + h * 64 + jt * 16 + fr; const float bav = p.ba[cj], bxv = p.bx[cj], sp = p.spl[cj];
#pragma unroll
          for (int jj = 0; jj < 4; ++jj) { const int t = fq * 4 + jj; const float r = sigm(pa[jj] + bav), ig = sigm(px[jj] + bxv); const float la = -8.f * r * sp;
              const float a = fexp(la); float mult = sqrtf(fmaxf(1.f - fexp(2.f * la), 0.f)); if (t0 + t == 0) mult = 1.f;
              const int li = t * 66 + jt * 16 + fr; const float xcv = xf[li]; sa[li] = a; xf[li] = mult * ig * xcv; }
      } }
    lds_barrier();
    float Ac[16], Hl[16];
    { float A = 1.f, H = 0.f;
#pragma unroll
      for (int i = 0; i < 16; ++i) { const float a = sa[i * 66 + lane], bt = xf[i * 66 + lane]; H = a * H + bt; A *= a; Ac[i] = A; Hl[i] = H; }
      ct[(wid * 64 + lane) * 2] = A; ct[(wid * 64 + lane) * 2 + 1] = H; }
    lds_barrier();
    { float Ain = 1.f, Hin = 0.f;
      for (int w = 0; w < wid; ++w) { const float aw = ct[(w * 64 + lane) * 2], hw = ct[(w * 64 + lane) * 2 + 1]; Hin = aw * Hin + hw; Ain *= aw; }
      float* sc = (float*)p.hbuf + ((((size_t)b * 4 + h) * 16 + seg) * 8 + wid) * 2048 + lane * 16;
#pragma unroll
      for (int q = 0; q < 4; ++q) { f32x4 hv, av;
#pragma unroll
          for (int e = 0; e < 4; ++e) { const int i = q * 4 + e; hv[e] = Hl[i] + Ac[i] * Hin; av[e] = Ac[i] * Ain; }
          *(f32x4*)(sc + q * 4) = hv; *(f32x4*)(sc + 1024 + q * 4) = av; }
      if (wid == 7) { float* cw = p.lru_carry + (((size_t)b * 4 + h) * 16 + seg) * 128;
          cw[lane * 2] = Ac[15] * Ain; cw[lane * 2 + 1] = Hl[15] + Ac[15] * Hin; } }
}

__device__ __forceinline__ void lru_fix_item(const Params& p, int l, int item) {
    const int tid = opaque_tid(), wid = tid >> 6, lane = tid & 63;
    const int b = item >> 6, h = (item >> 4) & 3, seg = item & 15;
    const int t0 = seg * 128 + wid * 16; const size_t Tb = (size_t)b * SEQ;
    const int ch = h * 64 + lane;
    const float* sc = (const float*)p.hbuf + ((((size_t)b * 4 + h) * 16 + seg) * 8 + wid) * 2048 + lane * 16;
    f32x4 hv[4], av[4]; unsigned gr[16];
#pragma unroll
    for (int q = 0; q < 4; ++q) { hv[q] = *(const f32x4*)(sc + q * 4); av[q] = *(const f32x4*)(sc + 1024 + q * 4); }
#pragma unroll
    for (int i = 0; i < 16; ++i) gr[i] = p.z[(Tb + t0 + i) * ZLD + 2560 + ch];
    const float* car = p.lru_carry + (((size_t)b * 4 + h) * 16) * 128;
    float Hin = 0.f;
#pragma unroll 4
    for (int s = 0; s < seg; ++s) { const float as = car[s * 128 + lane * 2], hs = car[s * 128 + lane * 2 + 1]; Hin = as * Hin + hs; }
#pragma unroll
    for (int i = 0; i < 16; ++i) { const float hvv = hv[i >> 2][i & 3] + av[i >> 2][i & 3] * Hin; const size_t T = Tb + t0 + i;
        p.outs[((size_t)3 * M + T) * 256 + ch] = f2bf(hvv * gelu_t(bf2f(gr[i]))); }
}

__device__ __forceinline__ void hgrn_item(const Params& p, int l, int item, int pass, LAS unsigned char* lds) {
    const int tid = opaque_tid(), wid = tid >> 6, lane = tid & 63, fr = lane & 15, fq = lane >> 4;
    const int b = item >> 5, hp = (item >> 4) & 1, seg = item & 15;
    const int g4 = wid >> 2, wv = wid & 3, head = hp * 2 + g4;
    LAS unsigned char* gb = lds + g4 * 8192;
    LAS bf16_t* Qs = (LAS bf16_t*)gb; LAS bf16_t* Ks = (LAS bf16_t*)(gb + 2304); LAS bf16_t* KHt = (LAS bf16_t*)(gb + 4608);
    LAS float* decs = (LAS float*)(gb + 6656); LAS float* ssq = (LAS float*)(gb + 6912);
    const int kch = head * 64 + wv * 16 + fr;
    const float lbv = p.lbs[l * 256 + kch];
    const size_t iseg = ((size_t)b * 4 + head) * 16;
    f32x4 S[4];
#pragma unroll
    for (int kt = 0; kt < 4; ++kt) S[kt] = ZERO4;
    float segb = 0.f;
    float ng[4] = {0.f, 0.f, 0.f, 0.f};
    if (pass == 1) {
        for (int s = 0; s < seg; ++s) { const float* Sp = p.hgS + (iseg + s) * 4096 + wv * 16 + fr; const float* Dp = p.hgD + (iseg + s) * 64;
#pragma unroll
            for (int kt = 0; kt < 4; ++kt) { const f32x4 dl = *(const f32x4*)(Dp + kt * 16 + fq * 4);
#pragma unroll
                for (int j = 0; j < 4; ++j) S[kt][j] = fexp(dl[j]) * S[kt][j] + Sp[(kt * 16 + fq * 4 + j) * 64]; } }
#pragma unroll
        for (int j = 0; j < 4; ++j) ng[j] = p.hg_norm_g[l * 256 + head * 64 + wv * 16 + fq * 4 + j];
    }
    unsigned qn[4], fn[4], vn[4];
#define HG_LOAD(n_) do { const size_t T0_ = (size_t)b * SEQ + seg * 128 + (n_) * 16; \
        _Pragma("unroll") for (int j = 0; j < 4; ++j) { const bf16_t* zp = p.z + (T0_ + fq * 4 + j) * ZLD; qn[j] = zp[768 + kch]; fn[j] = zp[1024 + kch]; vn[j] = zp[1280 + kch]; } } while (0)
    HG_LOAD(0);
    for (int n = 0; n < 8; ++n) {
        const size_t T0 = (size_t)b * SEQ + seg * 128 + n * 16;
        float qv[4], fz[4]; unsigned vv[4];
#pragma unroll
        for (int j = 0; j < 4; ++j) { qv[j] = bf2f(qn[j]); fz[j] = bf2f(fn[j]); vv[j] = vn[j]; }
        if (n < 7) HG_LOAD(n + 1);
        u32x4 vw; vw.x = vv[0] | (vv[1] << 16); vw.y = vv[2] | (vv[3] << 16); vw.z = 0u; vw.w = 0u; const bf16x8 vfrag = as_bf8(vw);
        float cs[4], kf[4]; float run = 0.f;
#pragma unroll
        for (int j = 0; j < 4; ++j) { const float sg = sigm(fz[j]); const float f = lbv + (1.f - lbv) * sg; run += __logf(fmaxf(f, 1e-30f)); cs[j] = run; kf[j] = (1.f - lbv) * sigm(-fz[j]); }
        { const float t1 = __shfl(run, lane - 16), t2 = __shfl(run, lane - 32), t3 = __shfl(run, lane - 48);
          const float pre = (fq >= 1 ? t1 : 0.f) + (fq >= 2 ? t2 : 0.f) + (fq >= 3 ? t3 : 0.f);
#pragma unroll
          for (int j = 0; j < 4; ++j) cs[j] += pre; }
        const float blast = __shfl(cs[3], 48 + fr);
        lds_barrier();
        { u32x2 w; w.x = pk2(kf[0] * fexp(blast - cs[0]), kf[1] * fexp(blast - cs[1])); w.y = pk2(kf[2] * fexp(blast - cs[2]), kf[3] * fexp(blast - cs[3]));
          *(LAS u32x2*)(KHt + (wv * 16 + fr) * 16 + fq * 4) = w;
          if (fq == 0) decs[wv * 16 + fr] = fexp(blast);
          if (pass == 1) {
#pragma unroll
              for (int j = 0; j < 4; ++j) { const int s = fq * 4 + j; Qs[s * 72 + wv * 16 + fr] = f2bf(silu(qv[j]) * fexp(cs[j])); Ks[s * 72 + wv * 16 + fr] = f2bf(kf[j] * fexp(fminf(-cs[j], 80.f))); } } }
        segb += blast;
        lds_barrier();
        f32x4 o = ZERO4;
        if (pass == 1) {
            const bf16x8 ka0 = *(const LAS bf16x8*)(Ks + fr * 72 + fq * 8), ka1 = *(const LAS bf16x8*)(Ks + fr * 72 + 32 + fq * 8);
            const bf16x8 qb0 = *(const LAS bf16x8*)(Qs + fr * 72 + fq * 8), qb1 = *(const LAS bf16x8*)(Qs + fr * 72 + 32 + fq * 8);
            f32x4 sc = mfma16(ka0, qb0, ZERO4); sc = mfma16(ka1, qb1, sc);
#pragma unroll
            for (int j = 0; j < 4; ++j) sc[j] = (fq * 4 + j <= fr) ? sc[j] : 0.f;
            u32x4 pw; pw.x = pk2(sc[0], sc[1]); pw.y = pk2(sc[2], sc[3]); pw.z = 0u; pw.w = 0u;
            o = mfma16(vfrag, as_bf8(pw), o);
#pragma unroll
            for (int kk = 0; kk < 2; ++kk) {
                u32x4 sw; sw.x = pk2(S[2 * kk][0], S[2 * kk][1]); sw.y = pk2(S[2 * kk][2], S[2 * kk][3]); sw.z = pk2(S[2 * kk + 1][0], S[2 * kk + 1][1]); sw.w = pk2(S[2 * kk + 1][2], S[2 * kk + 1][3]);
                const u32x2 q0 = *(const LAS u32x2*)(Qs + fr * 72 + (2 * kk) * 16 + fq * 4), q1 = *(const LAS u32x2*)(Qs + fr * 72 + (2 * kk + 1) * 16 + fq * 4);
                u32x4 qw; qw.x = q0.x; qw.y = q0.y; qw.z = q1.x; qw.w = q1.y;
                o = mfma16(as_bf8(sw), as_bf8(qw), o);
            }
        }
#pragma unroll
        for (int kt = 0; kt < 4; ++kt) { const u32x2 kh = *(const LAS u32x2*)(KHt + (kt * 16 + fr) * 16 + fq * 4); u32x4 kw; kw.x = kh.x; kw.y = kh.y; kw.z = 0u; kw.w = 0u;
            const f32x4 dv = *(const LAS f32x4*)(decs + kt * 16 + fq * 4); S[kt] = mfma16(as_bf8(kw), vfrag, S[kt] * dv); }
        if (pass == 1) {
            float ss = o[0] * o[0] + o[1] * o[1] + o[2] * o[2] + o[3] * o[3]; ss += __shfl_xor(ss, 16); ss += __shfl_xor(ss, 32);
            if (fq == 0) ssq[wv * 16 + fr] = ss;
            lds_barrier();
            const float tot = ssq[fr] + ssq[16 + fr] + ssq[32 + fr] + ssq[48 + fr]; const float rstd = rsqrtf(tot * (1.f / 64.f) + EPS);
            const size_t T = T0 + fr; const u32x2 gw = *(const u32x2*)(p.z + T * ZLD + 1536 + head * 64 + wv * 16 + fq * 4);
            u32x2 w; w.x = pk2(o[0] * rstd * ng[0] * silu(bflo(gw.x)), o[1] * rstd * ng[1] * silu(bfhi(gw.x)));
            w.y = pk2(o[2] * rstd * ng[2] * silu(bflo(gw.y)), o[3] * rstd * ng[3] * silu(bfhi(gw.y)));
            *(u32x2*)(p.outs + ((size_t)1 * M + T) * 256 + head * 64 + wv * 16 + fq * 4) = w;
        }
    }
    if (pass == 0) {
        float* Sp = p.hgS + (iseg + seg) * 4096 + wv * 16 + fr;
#pragma unroll
        for (int kt = 0; kt < 4; ++kt)
#pragma unroll
            for (int j = 0; j < 4; ++j) Sp[(kt * 16 + fq * 4 + j) * 64] = S[kt][j];
        if (fq == 0) p.hgD[(iseg + seg) * 64 + wv * 16 + fr] = segb;
    }
    lds_barrier();
}

__device__ __forceinline__ void bgemm_phase(LAS unsigned char* lds, const bf16_t* outs, const bf16_t* wbr, const bf16_t* zg, bf16_t* merged) {
    using namespace pg8;
    const int tid = opaque_tid(), wid = __builtin_amdgcn_readfirstlane(tid >> 6), lane = tid & 63, fr = lane & 15, fq = lane >> 4;
    const int wm = wid >> 1, wn = wid & 1;
    unsigned voff[2], voffB[2];
#pragma unroll
    for (int i = 0; i < 2; ++i) { int R, C; stage_rc(tid * 16 + i * 8192, R, C); voff[i] = (unsigned)(R * 256 + C) * 2u; voffB[i] = (unsigned)(((R & ~31) + perm32(R & 31)) * 256 + C) * 2u; }
    const unsigned ldsw = (unsigned)wid * 1024u;
    const int aoff = (wm >> 1) * HTB + lds_byte((wm & 1) * 64 + fr, fq * 8);
    const int boff = 2 * HTB + lds_byte(wn * 64 + fr, fq * 8);
    constexpr int STG = 3 * HTB;
#define BG_LDX(dstoff, gbase, vo) do { _Pragma("unroll") for (int _i = 0; _i < 2; ++_i) \
        __builtin_amdgcn_global_load_lds((const unsigned*)((const char*)(gbase) + (vo)[_i]), (LAS unsigned*)(lds + (dstoff) + ldsw + _i * 8192), 16, 0, 0); } while (0)
#define BG_LD(dstoff, gbase) BG_LDX(dstoff, gbase, voff)
#define BG_STAGE(kk_, slot_) do { const int _n = (kk_) >> 2, _kt = (kk_) & 3; const int _so = (slot_) * STG; \
        const bf16_t* _a = outs + ((size_t)_n * M + (size_t)pm * 256) * 256 + _kt * 64; const bf16_t* _b = wbr + ((size_t)_n * 1024 + (size_t)pn * 128) * 256 + _kt * 64; \
        BG_LD(_so, _a); BG_LD(_so + HTB, _a + 128 * 256); BG_LDX(_so + 2 * HTB, _b, voffB); } while (0)
#define BG_COMPUTE(slot_) do { const LAS unsigned char* sb = lds + (slot_) * STG; \
        _Pragma("unroll") for (int k = 0; k < 2; ++k) { bf16x8 af[4], bw[4]; \
            _Pragma("unroll") for (int mi = 0; mi < 4; ++mi) af[mi] = *(const LAS bf16x8*)(sb + aoff + mi * 2048 + k * 1024); \
            _Pragma("unroll") for (int ni = 0; ni < 4; ++ni) bw[ni] = *(const LAS bf16x8*)(sb + boff + ni * 2048 + k * 1024); \
            _Pragma("unroll") for (int mi = 0; mi < 4; ++mi) _Pragma("unroll") for (int ni = 0; ni < 4; ++ni) acc[mi][ni] = mfma16(bw[ni], af[mi], acc[mi][ni]); } } while (0)
#define BG_WAIT(n) asm volatile("s_waitcnt vmcnt(" #n ")" ::: "memory")
#define BG_BAR() do { __builtin_amdgcn_s_barrier(); asm volatile("" ::: "memory"); } while (0)
    for (int u = opaque_bid(); u < 512; u += opaque_gd()) {
        const int up = (u & ~255) + (u & 7) * 32 + ((u & 255) >> 3);
        const int pm = up >> 3, pn = up & 7;
        f32x4 tot[4][4], acc[4][4];
#pragma unroll
        for (int mi = 0; mi < 4; ++mi)
#pragma unroll
            for (int ni = 0; ni < 4; ++ni) { tot[mi][ni] = ZERO4; acc[mi][ni] = ZERO4; }
        BG_STAGE(0, 0); BG_STAGE(1, 1);
        int slot = 0;
        for (int n = 0; n < 4; ++n) {
            const int kk0 = n * 4;
            BG_WAIT(6); BG_BAR(); { const int s2 = slot >= 1 ? slot - 1 : 2; BG_STAGE(kk0 + 2, s2); } BG_COMPUTE(slot); slot = slot == 2 ? 0 : slot + 1;
            BG_WAIT(6); BG_BAR(); { const int s2 = slot >= 1 ? slot - 1 : 2; BG_STAGE(kk0 + 3, s2); } BG_COMPUTE(slot); slot = slot == 2 ? 0 : slot + 1;
            BG_WAIT(6); BG_BAR(); if (n < 3) { const int s2 = slot >= 1 ? slot - 1 : 2; BG_STAGE(kk0 + 4, s2); } BG_COMPUTE(slot); slot = slot == 2 ? 0 : slot + 1;
            if (n < 3) { BG_WAIT(6); } else { BG_WAIT(0); }
            BG_BAR(); if (n < 3) { const int s2 = slot >= 1 ? slot - 1 : 2; BG_STAGE(kk0 + 5, s2); }
            size_t goff = (((size_t)n * 64 + pm) * 8 + pn) * 32768 + (size_t)(((wm * 4) * 4 + wn * 2) * 64 + fq * 16 + fr) * 8;
            asm volatile("" : "+v"(goff) :: "memory");
            const bf16_t* gp0 = zg + goff;
            u32x4 gv[2][2];
#pragma unroll
            for (int mi = 0; mi < 2; ++mi)
#pragma unroll
                for (int g = 0; g < 2; ++g) gv[mi][g] = *(const u32x4*)(gp0 + (mi * 4 + g) * 512);
            BG_COMPUTE(slot); slot = slot == 2 ? 0 : slot + 1;
#pragma unroll
            for (int hf = 0; hf < 2; ++hf) {
                u32x4 gn[2][2];
                if (hf == 0) {
#pragma unroll
                    for (int mi = 0; mi < 2; ++mi)
#pragma unroll
                        for (int g = 0; g < 2; ++g) gn[mi][g] = *(const u32x4*)(gp0 + ((2 + mi) * 4 + g) * 512);
                }
#pragma unroll
                for (int mi = 0; mi < 2; ++mi)
#pragma unroll
                    for (int g = 0; g < 2; ++g) { const u32x4 gq = gv[mi][g]; const int m2 = hf * 2 + mi;
                        tot[m2][2 * g][0] += sigm(bflo(gq.x)) * acc[m2][2 * g][0]; tot[m2][2 * g][1] += sigm(bfhi(gq.x)) * acc[m2][2 * g][1];
                        tot[m2][2 * g][2] += sigm(bflo(gq.y)) * acc[m2][2 * g][2]; tot[m2][2 * g][3] += sigm(bfhi(gq.y)) * acc[m2][2 * g][3];
                        tot[m2][2 * g + 1][0] += sigm(bflo(gq.z)) * acc[m2][2 * g + 1][0]; tot[m2][2 * g + 1][1] += sigm(bfhi(gq.z)) * acc[m2][2 * g + 1][1];
                        tot[m2][2 * g + 1][2] += sigm(bflo(gq.w)) * acc[m2][2 * g + 1][2]; tot[m2][2 * g + 1][3] += sigm(bfhi(gq.w)) * acc[m2][2 * g + 1][3];
                        acc[m2][2 * g] = ZERO4; acc[m2][2 * g + 1] = ZERO4; }
                if (hf == 0) {
#pragma unroll
                    for (int mi = 0; mi < 2; ++mi)
#pragma unroll
                        for (int g = 0; g < 2; ++g) gv[mi][g] = gn[mi][g];
                }
            }
        }
#pragma unroll
        for (int mi = 0; mi < 4; ++mi) { size_t ooff = (size_t)(pm * 256 + wm * 64 + mi * 16 + fr) * D + pn * 128 + wn * 64 + fq * 8; asm volatile("" : "+v"(ooff)); bf16_t* op = merged + ooff;
#pragma unroll
            for (int g = 0; g < 2; ++g) { u32x4 w; w.x = pk2(tot[mi][2 * g][0], tot[mi][2 * g][1]); w.y = pk2(tot[mi][2 * g][2], tot[mi][2 * g][3]);
                w.z = pk2(tot[mi][2 * g + 1][0], tot[mi][2 * g + 1][1]); w.w = pk2(tot[mi][2 * g + 1][2], tot[mi][2 * g + 1][3]); *(u32x4*)(op + g * 32) = w; } }
        BG_BAR();
    }
    asm volatile("s_waitcnt vmcnt(0)" ::: "memory"); __syncthreads();
#undef BG_LD
#undef BG_LDX
#undef BG_STAGE
#undef BG_COMPUTE
#undef BG_WAIT
#undef BG_BAR
}

__device__ __forceinline__ void run_phase(const LAS Params* lp, int ph, LAS unsigned char* lds) {
    if (ph == 0) { const Params p = fetchP(lp); phase0(p, lds); return; }
    const int l = (ph - 1) / 7, s = (ph - 1) - l * 7;
    const int G = opaque_gd(), c = opaque_bid();
    switch (s) {
    case 0: { const Params p = fetchP(lp); pg8::Gemm g{p.hbuf, p.wt_in + (size_t)l * 6912 * 1024, M, 6912, 1024, 30, 0}; pg8::EpiZG E{p.z, p.z + ZG_OFF}; pg8::gemm_phase(lds, g, G, c, E);
              if (l < 3 && G == 256 && c >= 192) conv_range(p, lds, (l + 1) * 4352, (l + 1) * 4352 + 1152, c - 192, 64); } break;
    case 1: for (int it = opaque_bid(); it < 1280; it += opaque_gd()) { const Params p = fetchP(lp); const int jx = (it & ~255) + (it & 7) * 32 + ((it & 255) >> 3);
            if (it < 256) hgrn_item(p, l, jx, 0, lds); else if (it < 768) attn_item(p, l, jx - 256, lds); else lru_item(p, l, jx - 768, lds); } break;
    case 2: for (int it = opaque_bid(); it < 1280; it += opaque_gd()) { const Params p = fetchP(lp); const int jx = (it & ~255) + (it & 7) * 32 + ((it & 255) >> 3);
            if (it < 256) hgrn_item(p, l, jx, 1, lds); else if (it < 768) gmlp_item(p, l, jx - 256, lds); else lru_fix_item(p, l, jx - 768); } break;
    case 3: { const Params p = fetchP(lp); bgemm_phase(lds, p.outs, p.wt_br + (size_t)l * 4096 * 256, p.z + ZG_OFF, p.hbuf); } break;
    case 4: { const Params p = fetchP(lp); pg8::Gemm g{p.hbuf, p.wt_out + (size_t)l * 1024 * 1024, M, 1024, 1024, 30, 0};
              const unsigned tgt = 32u * (unsigned)(2 * l + 1);
              pg8::EpiRms E{l == 0 ? p.x_in : (const float*)p.x, p.x, p.n_mix_post + l * D, p.n_ffn_pre + l * D, p.hbuf, {p.xslot, p.xcnt, tgt}, {p.xslot + 65536, p.xcnt + 4096, tgt}, l != 0, 1}; pg8::gemm_phase(lds, g, G, c, E); } break;
    case 5: { const Params p = fetchP(lp); pg8::Gemm g{p.hbuf, p.wt_f1 + (size_t)l * 5632 * 1024, M, 5632, 1024, 30, 0}; pg8::EpiSwi E{p.act, FF}; pg8::gemm_phase(lds, g, G, c, E);
              if (l < 3 && G == 256 && c >= 128) conv_range(p, lds, (l + 1) * 4352 + 1152, (l + 2) * 4352, c - 128, 128);
              if (l < 3 && G != 256) { conv_range(p, lds, (l + 1) * 4352, (l + 2) * 4352, c, G); } } break;
    default: { const Params p = fetchP(lp); pg8::Gemm g{p.act, p.wt_f2 + (size_t)l * 1024 * 2816, M, 1024, 2816, 30, 0};
              const unsigned tgt = 32u * (unsigned)(2 * l + 2);
              pg8::EpiRms E{p.x, p.x, p.n_ffn_post + l * D, l < 3 ? p.n_mix_pre + (l + 1) * D : nullptr, l < 3 ? p.hbuf : nullptr, {p.xslot, p.xcnt, tgt}, {p.xslot + 65536, p.xcnt + 4096, tgt}, 1, l < 3}; pg8::gemm_phase(lds, g, G, c, E); } break;
    }
}

__global__ void __launch_bounds__(512, 2) mega(Params p) {
    extern __shared__ __attribute__((aligned(16))) unsigned char smem[];
    LAS unsigned char* lds = (LAS unsigned char*)smem;
    LAS Params* lp = (LAS Params*)(lds + P_OFF);
    { const __attribute__((address_space(4))) unsigned long long* ka = (const __attribute__((address_space(4))) unsigned long long*)__builtin_amdgcn_kernarg_segment_ptr();
      if (threadIdx.x < sizeof(Params) / 8) ((LAS unsigned long long*)lp)[threadIdx.x] = ka[threadIdx.x]; }
    __syncthreads();
    cg::grid_group grid = cg::this_grid();
    volatile LAS unsigned* bst = (volatile LAS unsigned*)(lds + P_OFF + 448);
    if (threadIdx.x == 0) { bst[0] = 0u; bst[1] = 0u; }
    __syncthreads();
    const int lo = __builtin_amdgcn_readfirstlane(lp->ph_lo), hi = __builtin_amdgcn_readfirstlane(lp->ph_hi);
    if (hi - lo > 1 && threadIdx.x == 0) (void)xb_add(&((unsigned*)lds_u64(&lp->bar))[XB_XCNT(xb_xcc_id())], 1u);
#define GSYNC() xcd_barrier((unsigned*)lds_u64(&lp->bar), bst)
    for (int ph = lo; ph < hi; ++ph) {
        if (ph > lo) { if (hi > 4096) grid.sync(); else GSYNC(); }
        run_phase(lp, ph, lds);
#if 0
#endif
    }
}

extern "C" void kernel_launch(void* const* d_in, const int* in_sizes, int n_in, void* d_out, int out_size, void* d_ws, size_t ws_size, hipStream_t stream) {
    static int grid_blocks = 0;
    if (!grid_blocks) {
        int dev = 0, cus = 0, per_cu = 0;
        hipGetDevice(&dev);
        hipDeviceGetAttribute(&cus, hipDeviceAttributeMultiprocessorCount, dev);
        if (hipFuncSetAttribute((const void*)mega, hipFuncAttributeMaxDynamicSharedMemorySize, LDS_BYTES) != hipSuccess) { fprintf(stderr, "hipFuncSetAttribute failed\n"); grid_blocks = -1; return; }
        hipOccupancyMaxActiveBlocksPerMultiprocessor(&per_cu, (const void*)mega, 512, LDS_BYTES);
        if (per_cu < 1) { fprintf(stderr, "occupancy query says %d blocks per CU\n", per_cu); per_cu = 1; }
        (void)hipGetLastError();
        grid_blocks = cus * per_cu;
        if (n_in != 23 || ws_size < WS_END) { fprintf(stderr, "bad problem: n_in %d ws %zu need %zu\n", n_in, ws_size, (size_t)WS_END); grid_blocks = -1; }
    }
    if (grid_blocks < 0) return;
    Params p{};
    const float** f = (const float**)&p;
    for (int i = 0; i < 23; ++i) f[i] = (const float*)d_in[i];
    unsigned char* ws = (unsigned char*)d_ws;
    p.x = (float*)d_out;
    p.wt_in = (bf16_t*)(ws + OFF_WIN); p.wt_br = (bf16_t*)(ws + OFF_WBR); p.wt_out = (bf16_t*)(ws + OFF_WOUT); p.wt_f1 = (bf16_t*)(ws + OFF_WF1); p.wt_f2 = (bf16_t*)(ws + OFF_WF2);
    p.z = (bf16_t*)(ws + OFF_Z); p.hbuf = (bf16_t*)(ws + OFF_H); p.outs = (bf16_t*)(ws + OFF_OUTS); p.act = (bf16_t*)(ws + OFF_ACT);
    p.gmw = (bf16_t*)(ws + OFF_GMW); p.waT = (bf16_t*)(ws + OFF_WAT); p.wxT = (bf16_t*)(ws + OFF_WXT);
    p.y = (float*)(ws + OFF_Y); p.lbs = (float*)(ws + OFF_LBS); p.spl = (float*)(ws + OFF_SPL); p.lru_carry = (float*)(ws + OFF_LCAR); p.hgS = (float*)(ws + OFF_HGS); p.hgD = (float*)(ws + OFF_HGD); p.bar = (unsigned*)(ws + OFF_BAR); p.xcnt = (unsigned*)(ws + OFF_XCNT); p.xslot = (float*)(ws + OFF_XSLOT);
    (void)hipMemsetAsync(ws + OFF_BAR, 0, 16384 + 32768, stream);
#if MULTI_LAUNCH
    for (int ph = 0; ph < NPHASE; ++ph) { p.ph_lo = ph; p.ph_hi = ph + 1; hipLaunchKernelGGL(mega, dim3(grid_blocks), dim3(512), LDS_BYTES, stream, p); }
#else
    p.ph_lo = 0; p.ph_hi = NPHASE;
    void* args[] = {&p};
    hipError_t e = hipLaunchCooperativeKernel((const void*)mega, dim3(grid_blocks), dim3(512), args, LDS_BYTES, stream);
    if (e != hipSuccess) fprintf(stderr, "cooperative launch failed: %s (grid %d)\n", hipGetErrorString(e), grid_blocks);
#endif
}
```

```cpp
#include <hip/hip_runtime.h>
#include <hip/hip_cooperative_groups.h>
#include <cstdio>
namespace cg = cooperative_groups;

#ifndef PROBE_IT
#define PROBE_IT 0
#endif
#ifndef PROBE_REP
#define PROBE_REP 0
#endif
#ifndef MULTI_LAUNCH
#define MULTI_LAUNCH 0
#endif

#define LAS __attribute__((address_space(3)))
typedef unsigned short bf16_t;
typedef short bf16x8 __attribute__((ext_vector_type(8)));
typedef float f32x4 __attribute__((ext_vector_type(4)));
typedef unsigned u32x4 __attribute__((ext_vector_type(4)));
typedef unsigned u32x2 __attribute__((ext_vector_type(2)));

constexpr int D = 1024, SEQ = 2048, M = 16384, ZLD = 2816, FF = 2816;
constexpr size_t ZG_OFF = (size_t)M * ZLD;
constexpr float EPS = 1e-6f, LOG2E = 1.4426950408889634f;
constexpr int P_OFF = 147456;
constexpr int LDS_BYTES = P_OFF + 512;
constexpr int NPHASE = 29;

constexpr size_t SZ_WIN = (size_t)6912 * 1024 * 2, SZ_WBR = (size_t)4096 * 256 * 2, SZ_WOUT = (size_t)1024 * 1024 * 2, SZ_WF1 = (size_t)5632 * 1024 * 2, SZ_WF2 = (size_t)1024 * 2816 * 2;
constexpr size_t OFF_WIN = 0, OFF_WBR = OFF_WIN + 4 * SZ_WIN, OFF_WOUT = OFF_WBR + 4 * SZ_WBR, OFF_WF1 = OFF_WOUT + 4 * SZ_WOUT, OFF_WF2 = OFF_WF1 + 4 * SZ_WF1;
constexpr size_t OFF_Z = OFF_WF2 + 4 * SZ_WF2, SZ_Z = (size_t)M * 6912 * 2;
constexpr size_t OFF_Y = OFF_Z, OFF_ACT = OFF_Z + (size_t)M * D * 4;
constexpr size_t OFF_H = OFF_Z + SZ_Z, OFF_OUTS = OFF_H + (size_t)M * D * 2;
constexpr size_t OFF_GMW = OFF_OUTS + (size_t)M * D * 2;
constexpr size_t OFF_WAT = OFF_GMW + 524288, OFF_WXT = OFF_WAT + 131072, OFF_LBS = OFF_WXT + 131072, OFF_SPL = OFF_LBS + 4096;
constexpr size_t OFF_LCAR = OFF_SPL + 4096, OFF_HGS = OFF_LCAR + 262144, OFF_HGD = OFF_HGS + 8388608, OFF_BAR = OFF_HGD + 131072, OFF_XCNT = OFF_BAR + 16384, OFF_XSLOT = OFF_XCNT + 32768, WS_END = OFF_XSLOT + 524288;

#define PFIELDS(X) \
    X(const float*, x_in) X(const float*, n_mix_pre) X(const float*, n_mix_post) X(const float*, n_ffn_pre) X(const float*, n_ffn_post) X(const float*, w_in) \
    X(const float*, rel_bias) X(const float*, lb_logits) X(const float*, hg_norm_g) X(const float*, gm_norm_g) X(const float*, gm_ws) X(const float*, gm_bs) \
    X(const float*, conv_w) X(const float*, conv_b) X(const float*, wa) X(const float*, ba) X(const float*, wx) X(const float*, bx) X(const float*, lam) \
    X(const float*, w_branch) X(const float*, w_out) X(const float*, w_f1) X(const float*, w_f2) \
    X(float*, x) X(bf16_t*, wt_in) X(bf16_t*, wt_br) X(bf16_t*, wt_out) X(bf16_t*, wt_f1) X(bf16_t*, wt_f2) X(bf16_t*, z) X(bf16_t*, hbuf) X(bf16_t*, outs) X(bf16_t*, act) \
    X(bf16_t*, gmw) X(bf16_t*, waT) X(bf16_t*, wxT) X(float*, y) X(float*, lbs) X(float*, spl) X(float*, lru_carry) X(float*, hgS) X(float*, hgD) X(unsigned*, bar) X(unsigned*, xcnt) X(float*, xslot)
#define PDECL(T, n) T n;
struct Params { PFIELDS(PDECL) int ph_lo, ph_hi; };

__device__ __forceinline__ unsigned pk2(float lo, float hi) { unsigned r; asm("v_cvt_pk_bf16_f32 %0, %1, %2" : "=v"(r) : "v"(lo), "v"(hi)); return r; }
__device__ __forceinline__ unsigned pk2s(float lo, float hi) { unsigned r; asm("s_nop 0\n\tv_cvt_pk_bf16_f32 %0, %1, %2" : "=v"(r) : "v"(lo), "v"(hi)); return r; }
__device__ __forceinline__ bf16_t f2bf(float f) { return (bf16_t)(pk2(f, 0.f) & 0xffffu); }
__device__ __forceinline__ float bf2f(unsigned b) { return __uint_as_float(b << 16); }
__device__ __forceinline__ float bflo(unsigned w) { return __uint_as_float(w << 16); }
__device__ __forceinline__ float bfhi(unsigned w) { return __uint_as_float(w & 0xffff0000u); }
__device__ __forceinline__ float fexp2(float x) { return __builtin_amdgcn_exp2f(x); }
__device__ __forceinline__ float fexp(float x) { return __builtin_amdgcn_exp2f(x * LOG2E); }
__device__ __forceinline__ float frcp(float x) { return __builtin_amdgcn_rcpf(x); }
__device__ __forceinline__ float sigm(float x) { return frcp(1.f + fexp(-x)); }
__device__ __forceinline__ float silu(float x) { return x * sigm(x); }
__device__ __forceinline__ float gelu_t(float x) { return x * sigm(1.5957691216057308f * (x + 0.044715f * x * x * x)); }
__device__ __forceinline__ float wave_sum(float v) {
#pragma unroll
    for (int o = 32; o >= 1; o >>= 1) v += __shfl_xor(v, o);
    return v;
}
__device__ __forceinline__ bf16x8 as_bf8(u32x4 w) { return __builtin_bit_cast(bf16x8, w); }
__device__ __forceinline__ f32x4 mfma16(bf16x8 a, bf16x8 b, f32x4 c) { return __builtin_amdgcn_mfma_f32_16x16x32_bf16(a, b, c, 0, 0, 0); }
#define ZERO4 ((f32x4){0.f, 0.f, 0.f, 0.f})
__device__ __forceinline__ void lds_barrier() { asm volatile("s_waitcnt lgkmcnt(0)" ::: "memory"); __builtin_amdgcn_s_barrier(); asm volatile("" ::: "memory"); }
__device__ __forceinline__ int opaque_bid() { int t = blockIdx.x; asm volatile("" : "+s"(t)); return t; }
__device__ __forceinline__ int opaque_gd() { int t = gridDim.x; asm volatile("" : "+s"(t)); return t; }
__device__ __forceinline__ int opaque_tid() { int t = threadIdx.x; asm volatile("" : "+v"(t)); return t; }
__device__ __forceinline__ unsigned long long lds_u64(const LAS void* a) { const u32x2 v = *(const LAS u32x2*)a; const unsigned lo = __builtin_amdgcn_readfirstlane(v.x), hi = __builtin_amdgcn_readfirstlane(v.y); return ((unsigned long long)hi << 32) | lo; }
#define PFETCH(T, n) q.n = (T)(__attribute__((address_space(1))) void*)lds_u64(&lp->n);
__device__ __forceinline__ Params fetchP(const LAS Params* lp0) { unsigned la = (unsigned)(unsigned long long)lp0; asm volatile("" : "+v"(la)); const LAS Params* lp = (const LAS Params*)la; Params q; PFIELDS(PFETCH) q.ph_lo = 0; q.ph_hi = 0; return q; }

#define XB_TMO      128
#define XB_XCNT(j)  (256  + 64 * (j))
#define XB_XSUB(j)  (1280 + 64 * (j))
#define XB_XGEN(j)  (2304 + 64 * (j))
#define XB_TOP      3328
#define XB_TOPGEN   3392
#define XCD_BAR_WORDS 3456
#define XB_SPIN_CAP (1u << 22)
__device__ __forceinline__ unsigned xb_ld(unsigned* p)              { return __hip_atomic_load(p, __ATOMIC_RELAXED, __HIP_MEMORY_SCOPE_AGENT); }
__device__ __forceinline__ unsigned xb_add(unsigned* p, unsigned v) { return __hip_atomic_fetch_add(p, v, __ATOMIC_RELAXED, __HIP_MEMORY_SCOPE_AGENT); }
__device__ __forceinline__ unsigned xb_xcc_id() { return (unsigned)__builtin_amdgcn_s_getreg((3 << 11) | 20) & 0xFu; }
#define XB_SPIN(cond, bar) do { unsigned _sp = 0; while (cond) { __builtin_amdgcn_s_sleep(1); \
    if ((++_sp & 255u) == 0u) { if (xb_ld(&(bar)[XB_TMO])) break; if (_sp > XB_SPIN_CAP) { atomicAdd(&(bar)[XB_TMO], 1u); break; } } } } while (0)
__device__ __forceinline__ void xcd_barrier_complete(unsigned* bar, unsigned x, unsigned& nloc, unsigned& nx) {
    const unsigned G = gridDim.x;
    unsigned sum, cnt, mine, sp = 0u;
    for (;;) {
        sum = 0u; cnt = 0u; mine = 0u;
#pragma unroll
        for (unsigned j = 0; j < 16; ++j) { const unsigned c = xb_ld(&bar[XB_XCNT(j)]); sum += c; cnt += (c > 0u) ? 1u : 0u; mine = (j == x) ? c : mine; }
        if (sum == G) break;
        __builtin_amdgcn_s_sleep(1);
        if ((++sp & 255u) == 0u) { if (xb_ld(&bar[XB_TMO])) break; if (sp > XB_SPIN_CAP) { atomicAdd(&bar[XB_TMO], 1u); break; } }
    }
    nloc = mine > 0u ? mine : 1u; nx = cnt > 0u ? cnt : 1u;
}
__device__ __forceinline__ void xcd_barrier(unsigned* bar, volatile LAS unsigned* st) {
    asm volatile("s_waitcnt vmcnt(0)" ::: "memory");
    __syncthreads();
    if (threadIdx.x == 0) {
        const unsigned x = xb_xcc_id();
        __builtin_amdgcn_s_waitcnt(0);
        unsigned nloc = st[0], nx = st[1];
        if (nloc == 0u) { xcd_barrier_complete(bar, x, nloc, nx); st[0] = nloc; st[1] = nx; }
        const unsigned old = xb_add(&bar[XB_XSUB(x)], 1u);
        const unsigned gen = old / nloc;
        if (old + 1u == (gen + 1u) * nloc) {
            __builtin_amdgcn_fence(__ATOMIC_RELEASE, "agent");
            asm volatile("s_waitcnt vmcnt(0)" ::: "memory");
            const unsigned og = xb_add(&bar[XB_TOP], 1u);
            const unsigned tg = og / nx;
            if (og + 1u == (tg + 1u) * nx) xb_add(&bar[XB_TOPGEN], 1u);
            else XB_SPIN(xb_ld(&bar[XB_TOPGEN]) == tg, bar);
            __builtin_amdgcn_fence(__ATOMIC_ACQUIRE, "agent");
            xb_add(&bar[XB_XGEN(x)], 1u);
            asm volatile("s_waitcnt vmcnt(0)" ::: "memory");
        } else {
            XB_SPIN(xb_ld(&bar[XB_XGEN(x)]) == gen, bar);
            __builtin_amdgcn_fence(__ATOMIC_ACQUIRE, "agent");
            asm volatile("s_waitcnt vmcnt(0)" ::: "memory");
        }
    }
    __syncthreads();
}

namespace pg8 {
constexpr int BM = 256, BK = 64, HALF = 128, HTB = HALF * BK * 2, NXCD = 8, WGM = 6;
__device__ __forceinline__ int lds_byte(int r, int c) { const int st = (r >> 4) * 2 + (c >> 5), rr = r & 15, cc = c & 31, ob = rr * 64 + cc * 2; return st * 1024 + (ob ^ (((ob >> 9) & 1) << 5)); }
__device__ __forceinline__ void stage_rc(int b, int& R, int& C) { const int st = b / 1024, sb = b % 1024, swz = sb ^ (((sb >> 9) & 1) << 5); R = (st >> 1) * 16 + swz / 64; C = (st & 1) * 32 + (swz % 64) / 2; }
__device__ __forceinline__ int perm32(int rho) { const int n = rho >> 4, i = rho & 15; return 8 * (i >> 2) + 4 * n + (i & 3); }
struct Unit { int pm, pn; };
struct Gemm { const bf16_t* A; const bf16_t* Bt; int M, N, K; int ashift; size_t astride; };
struct StaticOrder {
    int nM, nN, nwg, G, c;
    __device__ void init(int M_, int N_, int G_, int c_) { nM = M_ / BM; nN = N_ / BM; nwg = nM * nN; G = G_; c = c_; }
    __device__ bool next(int i, Unit& u) const {
        const long L = (long)i * G + c; if (L >= nwg) return false;
        int wgid = (int)L; { const int q = nwg / NXCD, r = nwg % NXCD, xcd = wgid % NXCD, off = wgid / NXCD; wgid = (xcd < r ? xcd * (q + 1) : r * (q + 1) + (xcd - r) * q) + off; }
        const int nig = WGM * nN, gid = wgid / nig, fm = gid * WGM, gsz = (nM - fm) < WGM ? (nM - fm) : WGM;
        u.pm = fm + ((wgid % nig) % gsz); u.pn = (wgid % nig) / gsz; return true;
    }
};

struct EpiF32 {
    static constexpr bool PERM = false, AFTER_DRAIN = false;
    float* C; int ldc;
    __device__ __forceinline__ void operator()(const f32x4 (&acc)[2][2][4][2], const Unit& u, int wr, int wc, int fr, int fq) const {
        const int row0 = u.pm * BM + wr * 64 + fr, col0 = u.pn * BM + wc * 32 + 4 * fq;
#pragma unroll
        for (int ai = 0; ai < 2; ++ai)
#pragma unroll
            for (int m = 0; m < 4; ++m) { float* rowp = C + (size_t)(row0 + ai * HALF + m * 16) * ldc + col0;
#pragma unroll
                for (int bj = 0; bj < 2; ++bj)
#pragma unroll
                    for (int n = 0; n < 2; ++n) *(f32x4*)(rowp + bj * HALF + n * 16) = acc[ai][bj][m][n]; }
    }
};
struct EpiZ {
    static constexpr bool PERM = true, AFTER_DRAIN = false;
    bf16_t* O; int ldc;
    __device__ __forceinline__ void operator()(const f32x4 (&acc)[2][2][4][2], const Unit& u, int wr, int wc, int fr, int fq) const {
        const int row0 = u.pm * BM + wr * 64 + fr, col0 = u.pn * BM + wc * 32 + 8 * fq;
#pragma unroll
        for (int ai = 0; ai < 2; ++ai)
#pragma unroll
            for (int m = 0; m < 4; ++m) { bf16_t* rowp = O + (size_t)(row0 + ai * HALF + m * 16) * ldc + col0;
#pragma unroll
                for (int bj = 0; bj < 2; ++bj) { const f32x4 v0 = acc[ai][bj][m][0], v1 = acc[ai][bj][m][1];
                    u32x4 w; w.x = pk2(v0[0], v0[1]); w.y = pk2(v0[2], v0[3]); w.z = pk2(v1[0], v1[1]); w.w = pk2(v1[2], v1[3]);
                    *(u32x4*)(rowp + bj * HALF) = w; } }
    }
};
struct EpiZG {
    static constexpr bool PERM = true, AFTER_DRAIN = false;
    bf16_t* O; bf16_t* Gt;
    __device__ __forceinline__ void operator()(const f32x4 (&acc)[2][2][4][2], const Unit& u, int wr, int wc, int fr, int fq) const {
        if (u.pn < 11) {
            const int row0 = u.pm * BM + wr * 64 + fr, col0 = u.pn * BM + wc * 32 + 8 * fq;
#pragma unroll
            for (int ai = 0; ai < 2; ++ai)
#pragma unroll
                for (int m = 0; m < 4; ++m) { bf16_t* rowp = O + (size_t)(row0 + ai * HALF + m * 16) * ZLD + col0;
#pragma unroll
                    for (int bj = 0; bj < 2; ++bj) { const f32x4 v0 = acc[ai][bj][m][0], v1 = acc[ai][bj][m][1];
                        u32x4 w; w.x = pk2(v0[0], v0[1]); w.y = pk2(v0[2], v0[3]); w.z = pk2(v1[0], v1[1]); w.w = pk2(v1[2], v1[3]);
                        *(u32x4*)(rowp + bj * HALF) = w; } }
        } else {
            const int g = u.pn - 11, n = g >> 2, q = g & 3;
            bf16_t* blk = Gt + (((size_t)n * 64 + u.pm) * 8 + q * 2) * 32768 + (size_t)((wr * 4 * 4 + wc) * 64 + fq * 16 + fr) * 8;
#pragma unroll
            for (int ai = 0; ai < 2; ++ai)
#pragma unroll
                for (int m = 0; m < 4; ++m)
#pragma unroll
                    for (int bj = 0; bj < 2; ++bj) { const f32x4 v0 = acc[ai][bj][m][0], v1 = acc[ai][bj][m][1];
                        u32x4 w; w.x = pk2(v0[0], v0[1]); w.y = pk2(v0[2], v0[3]); w.z = pk2(v1[0], v1[1]); w.w = pk2(v1[2], v1[3]);
                        *(u32x4*)(blk + (size_t)bj * 32768 + (size_t)((ai * 8 + m) * 4) * 512) = w; }
        }
    }
};
struct EpiSwi {
    static constexpr bool PERM = true, AFTER_DRAIN = false;
    bf16_t* O; int ldc;
    __device__ __forceinline__ void operator()(const f32x4 (&acc)[2][2][4][2], const Unit& u, int wr, int wc, int fr, int fq) const {
        const int row0 = u.pm * BM + wr * 64 + fr, col0 = u.pn * HALF + wc * 32 + 8 * fq;
#pragma unroll
        for (int ai = 0; ai < 2; ++ai)
#pragma unroll
            for (int m = 0; m < 4; ++m) { bf16_t* rowp = O + (size_t)(row0 + ai * HALF + m * 16) * ldc + col0;
                const f32x4 g0 = acc[ai][0][m][0], g1 = acc[ai][0][m][1], u0 = acc[ai][1][m][0], u1 = acc[ai][1][m][1];
                u32x4 w; w.x = pk2(silu(g0[0]) * u0[0], silu(g0[1]) * u0[1]); w.y = pk2(silu(g0[2]) * u0[2], silu(g0[3]) * u0[3]);
                w.z = pk2(silu(g1[0]) * u1[0], silu(g1[1]) * u1[1]); w.w = pk2(silu(g1[2]) * u1[2], silu(g1[3]) * u1[3]);
                *(u32x4*)rowp = w; }
    }
};

struct RmsX { float* slots; unsigned* cnt; unsigned target; };
struct EpiRms {
    static constexpr bool PERM = false, AFTER_DRAIN = true;
    const float* xin; float* x; const float* g1; const float* g2; bf16_t* h; RmsX e1, e2; int lin_in, lin_out;
    __device__ __forceinline__ void stats(const f32x4 (&v)[2][2][4][2], const Unit& u, int wr, int wc, int fr, int fq, LAS unsigned char* lds, int wid, int lane, const RmsX& e) const {
        LAS float* P = (LAS float*)lds; LAS float* S = (LAS float*)(lds + 4096);
#pragma unroll
        for (int ai = 0; ai < 2; ++ai)
#pragma unroll
            for (int m = 0; m < 4; ++m) { float s = 0.f;
#pragma unroll
                for (int bj = 0; bj < 2; ++bj)
#pragma unroll
                    for (int n = 0; n < 2; ++n) { const f32x4 t = v[ai][bj][m][n]; s += (t[0] * t[0] + t[1] * t[1]) + (t[2] * t[2] + t[3] * t[3]); }
                s += __shfl_xor(s, 16); s += __shfl_xor(s, 32);
                if (fq == 0) P[(ai * HALF + wr * 64 + m * 16 + fr) * 4 + wc] = s; }
        asm volatile("s_waitcnt lgkmcnt(0)" ::: "memory"); __builtin_amdgcn_s_barrier(); asm volatile("" ::: "memory");
        const int row = wid * 32 + (lane & 31);
        if (lane < 32) { const float t = (P[row * 4] + P[row * 4 + 1]) + (P[row * 4 + 2] + P[row * 4 + 3]);
            __hip_atomic_store((unsigned*)(e.slots + ((size_t)(u.pm * BM + row) * 4 + u.pn)), __float_as_uint(t), __ATOMIC_RELAXED, __HIP_MEMORY_SCOPE_AGENT); }
        asm volatile("s_waitcnt vmcnt(0)" ::: "memory");
        if (lane == 0) __hip_atomic_fetch_add(e.cnt + 64 * u.pm, 1u, __ATOMIC_RELAXED, __HIP_MEMORY_SCOPE_AGENT);
        if (wid == 0) { unsigned sp = 0;
            while ((unsigned)__builtin_amdgcn_readfirstlane(__hip_atomic_load(e.cnt + 64 * u.pm, __ATOMIC_RELAXED, __HIP_MEMORY_SCOPE_AGENT)) < e.target) { __builtin_amdgcn_s_sleep(2); if (++sp > (1u << 22)) break; }
            __builtin_amdgcn_fence(__ATOMIC_ACQUIRE, "agent"); }
        asm volatile("s_waitcnt vmcnt(0) lgkmcnt(0)" ::: "memory"); __builtin_amdgcn_s_barrier(); asm volatile("" ::: "memory");
        if (lane < 32) { const unsigned* sl = (const unsigned*)(e.slots + (size_t)(u.pm * BM + row) * 4); float t = 0.f;
#pragma unroll
            for (int k = 0; k < 4; ++k) t += __uint_as_float(__hip_atomic_load(sl + k, __ATOMIC_RELAXED, __HIP_MEMORY_SCOPE_AGENT));
            S[row] = rsqrtf(t * (1.f / 1024.f) + EPS); }
        asm volatile("s_waitcnt lgkmcnt(0)" ::: "memory"); __builtin_amdgcn_s_barrier(); asm volatile("" ::: "memory");
    }
    __device__ __forceinline__ void fused(f32x4 (&acc)[2][2][4][2], const Unit& u, int wr, int wc, int fr, int fq, LAS unsigned char* lds, int wid, int lane) const {
        const LAS float* S = (const LAS float*)(lds + 4096);
        const int col0 = u.pn * BM + wc * 32 + 4 * fq;
        stats(acc, u, wr, wc, fr, fq, lds, wid, lane, e1);
        const bool defer = lin_in && !lin_out;
#pragma unroll
        for (int ai = 0; ai < 2; ++ai)
#pragma unroll
            for (int m = 0; m < 4; ++m) { const int r = ai * HALF + wr * 64 + m * 16 + fr; const float rs = S[r]; const int rb = ai * 8 + wr * 4 + m;
#pragma unroll
                for (int bj = 0; bj < 2; ++bj)
#pragma unroll
                    for (int n = 0; n < 2; ++n) { const size_t orm = (size_t)(u.pm * BM + r) * D + col0 + bj * HALF + n * 16, oln = (size_t)(u.pm * BM + rb * 16 + 8 * bj + 2 * wc + n) * D + u.pn * BM + lane * 4;
                        const f32x4 xv = *(const f32x4*)(xin + (lin_in ? oln : orm)); const f32x4 gv = *(const f32x4*)(g1 + col0 + bj * HALF + n * 16);
                        const f32x4 o = xv + acc[ai][bj][m][n] * rs * gv; acc[ai][bj][m][n] = o; if (!defer) *(f32x4*)(x + (lin_out ? oln : orm)) = o; }
                asm volatile("" : "+v"(acc[ai][0][m][0]), "+v"(acc[ai][0][m][1]), "+v"(acc[ai][1][m][0]), "+v"(acc[ai][1][m][1]));
                asm volatile("" ::: "memory"); }
        if (defer) {
            asm volatile("s_waitcnt vmcnt(0)" ::: "memory"); __builtin_amdgcn_s_barrier(); asm volatile("" ::: "memory");
#pragma unroll
            for (int ai = 0; ai < 2; ++ai)
#pragma unroll
                for (int m = 0; m < 4; ++m) { const int r = ai * HALF + wr * 64 + m * 16 + fr; float* xp = x + (size_t)(u.pm * BM + r) * D + col0;
#pragma unroll
                    for (int bj = 0; bj < 2; ++bj)
#pragma unroll
                        for (int n = 0; n < 2; ++n) *(f32x4*)(xp + bj * HALF + n * 16) = acc[ai][bj][m][n]; }
        }
        if (h) {
            stats(acc, u, wr, wc, fr, fq, lds, wid, lane, e2);
#pragma unroll
            for (int ai = 0; ai < 2; ++ai)
#pragma unroll
                for (int m = 0; m < 4; ++m) { const int r = ai * HALF + wr * 64 + m * 16 + fr; const float rs = S[r]; bf16_t* hp = h + (size_t)(u.pm * BM + r) * D + col0;
#pragma unroll
                    for (int bj = 0; bj < 2; ++bj)
#pragma unroll
                        for (int n = 0; n < 2; ++n) { const f32x4 gv = *(const f32x4*)(g2 + col0 + bj * HALF + n * 16); const f32x4 o = acc[ai][bj][m][n] * rs * gv;
                            u32x2 w; w.x = pk2(o[0], o[1]); w.y = pk2(o[2], o[3]); *(u32x2*)(hp + bj * HALF + n * 16) = w; }
                    asm volatile("" ::: "memory"); }
        }
    }
};

template <class Epi>
__device__ __forceinline__ void gemm_phase(LAS unsigned char* lds, const Gemm g, const int G, const int cidx, const Epi& E) {
    const int tid = opaque_tid(), wid = __builtin_amdgcn_readfirstlane(tid >> 6), lane = tid & 63, wr = wid >> 2, wc = wid & 3, fr = lane & 15, fq = lane >> 4;
    const int K = g.K, nt = K / BK;
    StaticOrder S; S.init(g.M, g.N, G, cidx);
    unsigned voffA[2], voffB[2];
#pragma unroll
    for (int i = 0; i < 2; ++i) { int R, C; stage_rc(tid * 16 + i * 8192, R, C); const int Rb = Epi::PERM ? ((R & ~31) + perm32(R & 31)) : R;
        voffA[i] = (unsigned)(R * K + C) * 2u; voffB[i] = (unsigned)(Rb * K + C) * 2u; }
    const size_t kstep = (size_t)(BK * 2);
    const size_t hstep = (size_t)HALF * K * 2;
    const size_t tstep = 2 * hstep;
    const unsigned ldsw = (unsigned)wid * 1024u;
    const int aoff = lds_byte(wr * 64 + fr, fq * 8), boff = lds_byte(wc * 32 + fr, fq * 8);
#define PG8_SA(b, h) (((b) * 2 + (h)) * HTB)
#define PG8_SB(b, h) ((4 + (b) * 2 + (h)) * HTB)
#define PG8_STAGE(bufoff, gbase, voff) do { _Pragma("unroll") for (int _i = 0; _i < 2; ++_i) \
        __builtin_amdgcn_global_load_lds((const unsigned*)((const char*)(gbase) + (voff)[_i]), (LAS unsigned*)(lds + (bufoff) + ldsw + _i * 8192), 16, 0, 0); } while (0)
#define PG8_LDA(dst, b, h) do { _Pragma("unroll") for (int m = 0; m < 4; ++m) _Pragma("unroll") for (int k = 0; k < 2; ++k) dst[m][k] = *(const LAS bf16x8*)(lds + PG8_SA(b, h) + aoff + m * 2048 + k * 1024); } while (0)
#define PG8_LDB(dst, b, h) do { _Pragma("unroll") for (int n = 0; n < 2; ++n) _Pragma("unroll") for (int k = 0; k < 2; ++k) dst[n][k] = *(const LAS bf16x8*)(lds + PG8_SB(b, h) + boff + n * 2048 + k * 1024); } while (0)
#define PG8_MMA(ai, bj, At, Bt) do { __builtin_amdgcn_s_setprio(1); _Pragma("unroll") for (int m = 0; m < 4; ++m) _Pragma("unroll") for (int n = 0; n < 2; ++n) _Pragma("unroll") for (int k = 0; k < 2; ++k) \
        acc[ai][bj][m][n] = __builtin_amdgcn_mfma_f32_16x16x32_bf16(Bt[n][k], At[m][k], acc[ai][bj][m][n], 0, 0, 0); __builtin_amdgcn_s_setprio(0); } while (0)
#define PG8_WAIT_V(n) asm volatile("s_waitcnt vmcnt(" #n ")" ::: "memory")
#define PG8_WAIT_L(n) asm volatile("s_waitcnt lgkmcnt(" #n ")" ::: "memory")
#define PG8_BAR __builtin_amdgcn_s_barrier()
#define PG8_SCHED __builtin_amdgcn_sched_barrier(0)
#define PG8_ABASE(u) ((const char*)g.A + (size_t)((u).pn >> g.ashift) * g.astride + (size_t)(u).pm * tstep)
    Unit cur, nxt; int ui = 0;
    if (!S.next(0, cur)) return;
    f32x4 acc[2][2][4][2];
#pragma unroll
    for (int a = 0; a < 2; ++a)
#pragma unroll
        for (int b = 0; b < 2; ++b)
#pragma unroll
            for (int m = 0; m < 4; ++m)
#pragma unroll
                for (int n = 0; n < 2; ++n) acc[a][b][m][n] = ZERO4;
    bf16x8 At[4][2], B0[2][2], B1[2][2];
    const char* cA = PG8_ABASE(cur); const char* cB = (const char*)g.Bt + (size_t)cur.pn * tstep;
    PG8_STAGE(PG8_SB(0, 0), cB, voffB); PG8_STAGE(PG8_SB(0, 1), cB + hstep, voffB); PG8_STAGE(PG8_SA(0, 0), cA, voffA); PG8_STAGE(PG8_SA(0, 1), cA + hstep, voffA);
    if (wr == 1) PG8_BAR;
    PG8_WAIT_V(2); PG8_BAR;
    PG8_STAGE(PG8_SB(1, 0), cB + kstep, voffB); PG8_STAGE(PG8_SA(1, 0), cA + kstep, voffA); PG8_STAGE(PG8_SB(1, 1), cB + hstep + kstep, voffB);
    PG8_WAIT_V(6); PG8_BAR;
    for (;;) {
        const bool has_next = S.next(ui + 1, nxt);
        const char* nA = has_next ? PG8_ABASE(nxt) : cA; const char* nB = has_next ? (const char*)g.Bt + (size_t)nxt.pn * tstep : cB;
        for (int t = 0; t < nt; t += 2) {
            const bool last = (t == nt - 2);
            const char* a1 = cA + (size_t)(t + 1) * kstep;
            const char* a2 = last ? nA : cA + (size_t)(t + 2) * kstep; const char* b2 = last ? nB : cB + (size_t)(t + 2) * kstep;
            const char* a3 = a2 + kstep; const char* b3 = b2 + kstep;
            PG8_LDB(B0, 0, 0); PG8_LDB(B1, 0, 1); PG8_SCHED; PG8_LDA(At, 0, 0); PG8_STAGE(PG8_SA(1, 1), a1 + hstep, voffA);
            PG8_WAIT_V(8); PG8_WAIT_L(0); PG8_BAR; PG8_MMA(0, 0, At, B0); PG8_MMA(0, 1, At, B1); PG8_BAR; PG8_SCHED;
            PG8_LDA(At, 0, 1); PG8_STAGE(PG8_SB(0, 0), b2, voffB); PG8_STAGE(PG8_SB(0, 1), b2 + hstep, voffB); PG8_STAGE(PG8_SA(0, 0), a2, voffA);
            PG8_WAIT_V(8); PG8_WAIT_L(0); PG8_BAR; PG8_MMA(1, 0, At, B0); PG8_MMA(1, 1, At, B1); PG8_BAR; PG8_SCHED;
            PG8_LDB(B0, 1, 0); PG8_LDB(B1, 1, 1); PG8_SCHED; PG8_LDA(At, 1, 0); PG8_STAGE(PG8_SA(0, 1), a2 + hstep, voffA);
            PG8_WAIT_V(8); PG8_WAIT_L(0); PG8_BAR; PG8_MMA(0, 0, At, B0); PG8_MMA(0, 1, At, B1); PG8_BAR; PG8_SCHED;
            PG8_LDA(At, 1, 1); PG8_STAGE(PG8_SB(1, 0), b3, voffB); PG8_STAGE(PG8_SB(1, 1), b3 + hstep, voffB); PG8_STAGE(PG8_SA(1, 0), a3, voffA);
            PG8_WAIT_V(8); PG8_WAIT_L(0); PG8_BAR; PG8_MMA(1, 0, At, B0); PG8_MMA(1, 1, At, B1); PG8_BAR; PG8_SCHED;
        }
        if constexpr (!Epi::AFTER_DRAIN) E(acc, cur, wr, wc, fr, fq);
        if (!has_next) break;
#pragma unroll
        for (int a = 0; a < 2; ++a)
#pragma unroll
            for (int b = 0; b < 2; ++b)
#pragma unroll
                for (int m = 0; m < 4; ++m)
#pragma unroll
                    for (int n = 0; n < 2; ++n) acc[a][b][m][n] = ZERO4;
        cur = nxt; cA = nA; cB = nB; ++ui;
    }
    PG8_WAIT_V(0);
    if (wr == 0) PG8_BAR;
    PG8_BAR;
    if constexpr (Epi::AFTER_DRAIN) E.fused(acc, cur, wr, wc, fr, fq, lds, wid, lane);
#undef PG8_SA
#undef PG8_SB
#undef PG8_STAGE
#undef PG8_LDA
#undef PG8_LDB
#undef PG8_MMA
#undef PG8_WAIT_V
#undef PG8_WAIT_L
#undef PG8_BAR
#undef PG8_SCHED
#undef PG8_ABASE
}
}

struct TDesc { const float* src; bf16_t* dst; int ld_src, ld_dst; };
__device__ __forceinline__ TDesc tile_desc(const Params& p, int i) {
    TDesc d; const int l = i / 4352; int r = i - l * 4352;
    if (r < 1728) { const int kt = r / 108, nt = r - kt * 108;
        d.src = p.w_in + (size_t)l * 1024 * 6912 + (size_t)(kt * 64) * 6912 + nt * 64; d.ld_src = 6912; d.dst = p.wt_in + (size_t)l * 6912 * 1024 + (size_t)(nt * 64) * 1024 + kt * 64; d.ld_dst = 1024; return d; }
    r -= 1728;
    if (r < 256) { const int n = r >> 6, rr = r & 63, kt = rr >> 4, nt = rr & 15;
        d.src = p.w_branch + ((size_t)l * 4 + n) * 256 * 1024 + (size_t)(kt * 64) * 1024 + nt * 64; d.ld_src = 1024; d.dst = p.wt_br + (size_t)l * 4096 * 256 + (size_t)(n * 1024 + nt * 64) * 256 + kt * 64; d.ld_dst = 256; return d; }
    r -= 256;
    if (r < 256) { const int kt = r >> 4, nt = r & 15;
        d.src = p.w_out + (size_t)l * 1024 * 1024 + (size_t)(kt * 64) * 1024 + nt * 64; d.ld_src = 1024; d.dst = p.wt_out + (size_t)l * 1024 * 1024 + (size_t)(nt * 64) * 1024 + kt * 64; d.ld_dst = 1024; return d; }
    r -= 256;
    if (r < 1408) { const int kt = r / 88, nt = r - kt * 88; const int n0 = nt * 64, bj = n0 / 2816, rem = n0 - bj * 2816, pn = rem >> 7, r0 = rem & 127;
        d.src = p.w_f1 + (size_t)l * 1024 * 5632 + (size_t)(kt * 64) * 5632 + n0; d.ld_src = 5632; d.dst = p.wt_f1 + (size_t)l * 5632 * 1024 + (size_t)(256 * pn + 128 * bj + r0) * 1024 + kt * 64; d.ld_dst = 1024; return d; }
    r -= 1408;
    { const int kt = r >> 4, nt = r & 15;
        d.src = p.w_f2 + (size_t)l * 2816 * 1024 + (size_t)(kt * 64) * 1024 + nt * 64; d.ld_src = 1024; d.dst = p.wt_f2 + (size_t)l * 1024 * 2816 + (size_t)(nt * 64) * 2816 + kt * 64; d.ld_dst = 2816; return d; }
}
__device__ __forceinline__ void norm_phase(const float* y, const float* gy, const float* xin, float* xo, const float* gn, bf16_t* h) {
    const int tid = opaque_tid(), wid = tid >> 6, lane = tid & 63;
    for (int row = opaque_bid() * 8 + wid; row < M; row += opaque_gd() * 8) {
        f32x4 xv[4]; const float* xr = xin + (size_t)row * D + lane * 4;
#pragma unroll
        for (int i = 0; i < 4; ++i) xv[i] = *(const f32x4*)(xr + i * 256);
        if (y) {
            f32x4 yv[4]; const bf16_t* yr = (const bf16_t*)y + (size_t)row * D + lane * 4; float ss = 0.f;
#pragma unroll
            for (int i = 0; i < 4; ++i) { const u32x2 yw = *(const u32x2*)(yr + i * 256); yv[i] = (f32x4){bflo(yw.x), bfhi(yw.x), bflo(yw.y), bfhi(yw.y)}; ss += yv[i][0] * yv[i][0] + yv[i][1] * yv[i][1] + yv[i][2] * yv[i][2] + yv[i][3] * yv[i][3]; }
            ss = wave_sum(ss); const float rs = rsqrtf(ss * (1.f / 1024.f) + EPS);
#pragma unroll
            for (int i = 0; i < 4; ++i) { const f32x4 gv = *(const f32x4*)(gy + lane * 4 + i * 256); xv[i] += yv[i] * rs * gv; }
        }
        if (xo) {
#pragma unroll
            for (int i = 0; i < 4; ++i) *(f32x4*)(xo + (size_t)row * D + lane * 4 + i * 256) = xv[i];
        }
        if (h) {
            float ss = 0.f;
#pragma unroll
            for (int i = 0; i < 4; ++i) ss += xv[i][0] * xv[i][0] + xv[i][1] * xv[i][1] + xv[i][2] * xv[i][2] + xv[i][3] * xv[i][3];
            ss = wave_sum(ss); const float rs = rsqrtf(ss * (1.f / 1024.f) + EPS);
#pragma unroll
            for (int i = 0; i < 4; ++i) { const f32x4 gv = *(const f32x4*)(gn + lane * 4 + i * 256); const f32x4 o = xv[i] * rs * gv;
                u32x2 w; w.x = pk2(o[0], o[1]); w.y = pk2(o[2], o[3]); *(u32x2*)(h + (size_t)row * D + lane * 4 + i * 256) = w; }
        }
    }
}

__device__ __forceinline__ void conv_range(const Params& p, LAS unsigned char* lds, int t0, int t1, int rank, int nranks) {
    LAS float* tile = (LAS float*)lds;
    const int tid = opaque_tid(); const int r = tid >> 4, c4 = (tid & 15) * 4, n = tid >> 3, k8 = (tid & 7) * 8;
    int i = t0 + rank; f32x4 v0 = ZERO4, v1 = ZERO4;
    if (i < t1) { const TDesc d = tile_desc(p, i); v0 = *(const f32x4*)(d.src + (size_t)r * d.ld_src + c4); v1 = *(const f32x4*)(d.src + (size_t)(r + 32) * d.ld_src + c4); }
    for (; i < t1; i += nranks) {
        const TDesc d = tile_desc(p, i);
        lds_barrier();
        { LAS float* tp = tile + r * 65 + c4; tp[0] = v0[0]; tp[1] = v0[1]; tp[2] = v0[2]; tp[3] = v0[3]; tp += 32 * 65; tp[0] = v1[0]; tp[1] = v1[1]; tp[2] = v1[2]; tp[3] = v1[3]; }
        if (i + nranks < t1) { const TDesc dn = tile_desc(p, i + nranks); v0 = *(const f32x4*)(dn.src + (size_t)r * dn.ld_src + c4); v1 = *(const f32x4*)(dn.src + (size_t)(r + 32) * dn.ld_src + c4); }
        lds_barrier();
        float v[8];
#pragma unroll
        for (int q = 0; q < 8; ++q) v[q] = tile[(k8 + q) * 65 + n];
        u32x4 w; w.x = pk2(v[0], v[1]); w.y = pk2(v[2], v[3]); w.z = pk2(v[4], v[5]); w.w = pk2(v[6], v[7]);
        *(u32x4*)(d.dst + (size_t)n * d.ld_dst + k8) = w;
    }
    lds_barrier();
}

__device__ __forceinline__ void phase0(const Params& p, LAS unsigned char* lds) {
    conv_range(p, lds, 0, 4352, opaque_bid(), opaque_gd());
    const int gt = opaque_bid() * 512 + opaque_tid(), nth = opaque_gd() * 512;
    for (int i = gt; i < 262144; i += nth) { const int q = i & 127, pp = (i >> 7) & 127; p.gmw[i] = (q <= pp) ? f2bf(p.gm_ws[i]) : (bf16_t)0; }
    for (int i = gt; i < 65536; i += nth) { const int ii = i & 63, j = (i >> 6) & 63, lh = i >> 12; p.waT[i] = f2bf(p.wa[(lh * 64 + ii) * 64 + j]); p.wxT[i] = f2bf(p.wx[(lh * 64 + ii) * 64 + j]); }
    for (int i = gt; i < 1024; i += nth) p.spl[i] = log1pf(expf(-p.lam[i]));
    for (int i = gt; i < 256; i += nth) {
        const float a0 = p.lb_logits[i], a1 = p.lb_logits[256 + i], a2 = p.lb_logits[512 + i], a3 = p.lb_logits[768 + i];
        const float mx = fmaxf(fmaxf(a0, a1), fmaxf(a2, a3)); const float e0 = expf(a0 - mx), e1 = expf(a1 - mx), e2 = expf(a2 - mx), e3 = expf(a3 - mx);
        const float inv = 1.f / (e0 + e1 + e2 + e3);
        p.lbs[i] = 0.f; p.lbs[256 + i] = e1 * inv; p.lbs[512 + i] = (e1 + e2) * inv; p.lbs[768 + i] = (e1 + e2 + e3) * inv;
    }
    norm_phase(nullptr, nullptr, p.x_in, nullptr, p.n_mix_pre, p.hbuf);
}

typedef short v4i16_t __attribute__((ext_vector_type(4)));
__device__ __forceinline__ void attn_item(const Params& p, int l, int item, LAS unsigned char* lds) {
    const int tid = opaque_tid(), wid = tid >> 6, lane = tid & 63, fr = lane & 15, fq = lane >> 4;
    const int b = item >> 6, c = (item >> 1) & 31, hp = item & 1;
    const int hh = wid >> 2, head = hp * 2 + hh, q0 = (wid & 3) * 16;
    constexpr int KST = 272, VST = 288, KBUF = 64 * KST, BUFB = KBUF + 64 * VST;
    LAS float* bias_s = (LAS float*)(lds + 2 * BUFB);
    const bf16_t* zb = p.z + (size_t)b * SEQ * ZLD;
    lds_barrier();
    for (int i = tid; i < 640; i += 512) { const int h2 = i / 320, idx = i - h2 * 320; bias_s[i] = p.rel_bias[((size_t)l * 4 + hp * 2 + h2) * 320 + idx] * LOG2E; }
    const bf16_t* qp = zb + (size_t)(c * 64 + q0 + fr) * ZLD + head * 64 + fq * 8;
    const bf16x8 qf0 = *(const bf16x8*)qp, qf1 = *(const bf16x8*)(qp + 32);
    f32x4 o[4];
#pragma unroll
    for (int dt = 0; dt < 4; ++dt) o[dt] = ZERO4;
    float mrun = -1e30f, lsum = 0.f;
    const int jj0 = c >= 8 ? 0 : 8 - c;
    const int skey = tid >> 4, spc = tid & 15;
    u32x4 kr[2], vr[2];
#define ATT_LOAD(jj_) do { const bf16_t* kb_ = zb + (size_t)((c - 8 + (jj_)) * 64 + skey) * ZLD + hp * 128 + spc * 8; \
        kr[0] = *(const u32x4*)(kb_ + 256); vr[0] = *(const u32x4*)(kb_ + 512); kr[1] = *(const u32x4*)(kb_ + (size_t)32 * ZLD + 256); vr[1] = *(const u32x4*)(kb_ + (size_t)32 * ZLD + 512); } while (0)
    ATT_LOAD(jj0);
    for (int jj = jj0; jj <= 8; ++jj) {
        LAS unsigned char* Kb = lds + (jj & 1) * BUFB; LAS unsigned char* Vb = Kb + KBUF;
        *(LAS u32x4*)(Kb + skey * KST + spc * 16) = kr[0]; *(LAS u32x4*)(Kb + (skey + 32) * KST + spc * 16) = kr[1];
        *(LAS u32x4*)(Vb + skey * VST + spc * 16) = vr[0]; *(LAS u32x4*)(Vb + (skey + 32) * VST + spc * 16) = vr[1];
        if (jj < 8) ATT_LOAD(jj + 1);
        lds_barrier();
        f32x4 s[4];
#pragma unroll
        for (int kt = 0; kt < 4; ++kt) { const LAS unsigned char* kp = Kb + (kt * 16 + fr) * KST + hh * 128 + fq * 16;
            s[kt] = mfma16(*(const LAS bf16x8*)kp, qf0, ZERO4); s[kt] = mfma16(*(const LAS bf16x8*)(kp + 64), qf1, s[kt]); }
        const int base = (8 - jj) * 64 + q0 + fr;
        float cmax = -1e30f;
#pragma unroll
        for (int kt = 0; kt < 4; ++kt)
#pragma unroll
            for (int j = 0; j < 4; ++j) { const int dist = base - (kt * 16 + fq * 4 + j); const int idx = (dist < 256 ? dist : 256) + 63;
                const float sv = s[kt][j] * (0.125f * LOG2E) + bias_s[hh * 320 + idx]; s[kt][j] = sv; cmax = fmaxf(cmax, sv); }
        cmax = fmaxf(cmax, __shfl_xor(cmax, 16)); cmax = fmaxf(cmax, __shfl_xor(cmax, 32));
        const float mnew = fmaxf(mrun, cmax), alpha = fexp2(mrun - mnew); mrun = mnew;
        float ps = 0.f;
#pragma unroll
        for (int kt = 0; kt < 4; ++kt)
#pragma unroll
            for (int j = 0; j < 4; ++j) { const float e = fexp2(s[kt][j] - mnew); s[kt][j] = e; ps += e; }
        lsum = lsum * alpha + ps;
#pragma unroll
        for (int dt = 0; dt < 4; ++dt) o[dt] *= alpha;
#pragma unroll
        for (int i = 0; i < 2; ++i) {
            u32x4 pw; pw.x = pk2s(s[2 * i][0], s[2 * i][1]); pw.y = pk2s(s[2 * i][2], s[2 * i][3]); pw.z = pk2s(s[2 * i + 1][0], s[2 * i + 1][1]); pw.w = pk2s(s[2 * i + 1][2], s[2 * i + 1][3]);
            const bf16x8 pb = as_bf8(pw);
            const LAS unsigned char* vp = Vb + (32 * i + 4 * fq + (fr >> 2)) * VST + hh * 128 + (fr & 3) * 8;
#pragma unroll
            for (int dt = 0; dt < 4; ++dt) {
                const v4i16_t a0 = __builtin_amdgcn_ds_read_tr16_b64_v4i16((LAS v4i16_t*)(vp + dt * 32));
                const v4i16_t a1 = __builtin_amdgcn_ds_read_tr16_b64_v4i16((LAS v4i16_t*)(vp + 16 * VST + dt * 32));
                const bf16x8 av = __builtin_shufflevector(a0, a1, 0, 1, 2, 3, 4, 5, 6, 7);
                o[dt] = mfma16(av, pb, o[dt]); }
        }
    }
#undef ATT_LOAD
    lsum += __shfl_xor(lsum, 16); lsum += __shfl_xor(lsum, 32);
    const float inv = 1.f / lsum;
    bf16_t* op = p.outs + ((size_t)b * SEQ + c * 64 + q0 + fr) * 256 + head * 64 + fq * 4;
#pragma unroll
    for (int dt = 0; dt < 4; ++dt) { u32x2 w; w.x = pk2(o[dt][0] * inv, o[dt][1] * inv); w.y = pk2(o[dt][2] * inv, o[dt][3] * inv); *(u32x2*)(op + dt * 16) = w; }
}

__device__ __forceinline__ void gmlp_item(const Params& p, int l, int item, LAS unsigned char* lds) {
    const int tid = opaque_tid(), wid = tid >> 6, lane = tid & 63, fr = lane & 15, fq = lane >> 4;
    const int b = item >> 6, blk = (item >> 2) & 15, g = item & 3;
    LAS bf16_t* vnT = (LAS bf16_t*)lds;
    const size_t T0 = (size_t)b * SEQ + blk * 128;
    lds_barrier();
    const int nks = (wid >> 1) + 1;
    const size_t Tw = T0 + wid * 16 + fr;
    bf16x8 bwp[4]; u32x2 uwp[4];
    { const bf16_t* wp = p.gmw + (((size_t)l * 4 + g) * 128 + wid * 16 + fr) * 128 + fq * 8;
#pragma unroll
      for (int ks = 0; ks < 4; ++ks) bwp[ks] = *(const bf16x8*)(wp + (ks < nks ? ks : 0) * 32);
#pragma unroll
      for (int ct = 0; ct < 4; ++ct) uwp[ct] = *(const u32x2*)(p.z + Tw * ZLD + 1792 + g * 64 + ct * 16 + fq * 4); }
    const float bsv = p.gm_bs[((size_t)l * 4 + g) * 128 + wid * 16 + fr];
    { const int pp = tid >> 2, qd = tid & 3; const bf16_t* vp = p.z + (T0 + pp) * ZLD + 2048 + qd * 16;
      float keep[16]; float ss = 0.f;
#pragma unroll
      for (int i = 0; i < 16; ++i) keep[i] = 0.f;
#pragma unroll
      for (int gg = 0; gg < 4; ++gg) { const u32x4 w0 = *(const u32x4*)(vp + gg * 64), w1 = *(const u32x4*)(vp + gg * 64 + 8);
          const float v[16] = {bflo(w0.x), bfhi(w0.x), bflo(w0.y), bfhi(w0.y), bflo(w0.z), bfhi(w0.z), bflo(w0.w), bfhi(w0.w),
                               bflo(w1.x), bfhi(w1.x), bflo(w1.y), bfhi(w1.y), bflo(w1.z), bfhi(w1.z), bflo(w1.w), bfhi(w1.w)};
#pragma unroll
          for (int i = 0; i < 16; ++i) { const float ge = gelu_t(v[i]); ss += ge * ge; keep[i] = (gg == g) ? ge : keep[i]; } }
      ss += __shfl_xor(ss, 1); ss += __shfl_xor(ss, 2);
      const float rstd = rsqrtf(ss * (1.f / 256.f) + EPS);
      const float* ng = p.gm_norm_g + l * 256 + g * 64 + qd * 16;
#pragma unroll
      for (int i = 0; i < 16; ++i) vnT[(qd * 16 + i) * 136 + pp] = f2bf(keep[i] * rstd * ng[i]);
    }
    lds_barrier();
    { f32x4 acc[4];
#pragma unroll
      for (int ct = 0; ct < 4; ++ct) acc[ct] = ZERO4;
#pragma unroll
      for (int ks = 0; ks < 4; ++ks) if (ks < nks) {
#pragma unroll
          for (int ct = 0; ct < 4; ++ct) { const bf16x8 av = *(const LAS bf16x8*)(vnT + (ct * 16 + fr) * 136 + ks * 32 + fq * 8); acc[ct] = mfma16(av, bwp[ks], acc[ct]); } }
#pragma unroll
      for (int ct = 0; ct < 4; ++ct) { const u32x2 uw = uwp[ct];
          u32x2 w; w.x = pk2(gelu_t(bflo(uw.x)) * (acc[ct][0] + bsv), gelu_t(bfhi(uw.x)) * (acc[ct][1] + bsv));
          w.y = pk2(gelu_t(bflo(uw.y)) * (acc[ct][2] + bsv), gelu_t(bfhi(uw.y)) * (acc[ct][3] + bsv));
          *(u32x2*)(p.outs + ((size_t)2 * M + Tw) * 256 + g * 64 + ct * 16 + fq * 4) = w; }
    }
}

__device__ __forceinline__ void lru_item(const Params& p, int l, int item, LAS unsigned char* lds) {
    const int tid = opaque_tid(), wid = tid >> 6, lane = tid & 63, fr = lane & 15, fq = lane >> 4;
    const int b = item >> 6, h = (item >> 4) & 3, seg = item & 15;
    LAS unsigned char* wb = lds + wid * 10752;
    LAS bf16_t* xa = (LAS bf16_t*)wb; LAS float* xf = (LAS float*)(wb + 2304); LAS float* sa = (LAS float*)(wb + 6528);
    LAS float* ct = (LAS float*)(lds + 86016);
    const int t0 = seg * 128 + wid * 16; const size_t Tb = (size_t)b * SEQ;
    const int ch = h * 64 + lane;
    lds_barrier();
    unsigned xr[19];
#pragma unroll
    for (int i = 0; i < 19; ++i) { const int t = t0 - 3 + i; xr[i] = (t >= 0) ? (unsigned)p.z[(Tb + (t >= 0 ? t : 0)) * ZLD + 2304 + ch] : 0u; }
    bf16x8 wa0[4], wa1[4], wx0[4], wx1[4];
    { const bf16_t* wap = p.waT + (((size_t)l * 4 + h) * 64 + fr) * 64 + fq * 8; const bf16_t* wxp = p.wxT + (((size_t)l * 4 + h) * 64 + fr) * 64 + fq * 8;
#pragma unroll
      for (int jt = 0; jt < 4; ++jt) { wa0[jt] = *(const bf16x8*)(wap + jt * 1024); wa1[jt] = *(const bf16x8*)(wap + jt * 1024 + 32); wx0[jt] = *(const bf16x8*)(wxp + jt * 1024); wx1[jt] = *(const bf16x8*)(wxp + jt * 1024 + 32); } }
    { const float cb = p.conv_b[l * 256 + ch], cw0 = p.conv_w[(l * 4 + 0) * 256 + ch], cw1 = p.conv_w[(l * 4 + 1) * 256 + ch], cw2 = p.conv_w[(l * 4 + 2) * 256 + ch], cw3 = p.conv_w[(l * 4 + 3) * 256 + ch];
#pragma unroll
      for (int i = 0; i < 16; ++i) { const float xc = cb + bf2f(xr[i]) * cw0 + bf2f(xr[i + 1]) * cw1 + bf2f(xr[i + 2]) * cw2 + bf2f(xr[i + 3]) * cw3; xa[i * 72 + lane] = f2bf(xc); xf[i * 66 + lane] = xc; } }
    lds_barrier();
    { const bf16x8 a0 = *(const LAS bf16x8*)(xa + fr * 72 + fq * 8), a1 = *(const LAS bf16x8*)(xa + fr * 72 + 32 + fq * 8);
#pragma unroll
      for (int jt = 0; jt < 4; ++jt) {
          f32x4 pa = mfma16(a0, wa0[jt], ZERO4); pa = mfma16(a1, wa1[jt], pa);
          f32x4 px = mfma16(a0, wx0[jt], ZERO4); px = mfma16(a1, wx1[jt], px);
          const int cj = l * 256 + h * 64 + jt * 16 + fr; const float bav = p.ba[cj], bxv = p.bx[cj], sp = p.spl[cj];
#pragma unroll
          for (int jj = 0; jj < 4; ++jj) { const int t = fq * 4 + jj; const float r = sigm(pa[jj] + bav), ig = sigm(px[jj] + bxv); const float la = -8.f * r * sp;
              const float a = fexp(la); float mult = sqrtf(fmaxf(1.f - fexp(2.f * la), 0.f)); if (t0 + t == 0) mult = 1.f;
              const int li = t * 66 + jt * 16 + fr; const float xcv = xf[li]; sa[li] = a; xf[li] = mult * ig * xcv; }
      } }
    lds_barrier();
    float Ac[16], Hl[16];
    { float A = 1.f, H = 0.f;
#pragma unroll
      for (int i = 0; i < 16; ++i) { const float a = sa[i * 66 + lane], bt = xf[i * 66 + lane]; H = a * H + bt; A *= a; Ac[i] = A; Hl[i] = H; }
      ct[(wid * 64 + lane) * 2] = A; ct[(wid * 64 + lane) * 2 + 1] = H; }
    lds_barrier();
    { float Ain = 1.f, Hin = 0.f;
      for (int w = 0; w < wid; ++w) { const float aw = ct[(w * 64 + lane) * 2], hw = ct[(w * 64 + lane) * 2 + 1]; Hin = aw * Hin + hw; Ain *= aw; }
      float* sc = (float*)p.hbuf + ((((size_t)b * 4 + h) * 16 + seg) * 8 + wid) * 2048 + lane * 16;
#pragma unroll
      for (int q = 0; q < 4; ++q) { f32x4 hv, av;
#pragma unroll
          for (int e = 0; e < 4; ++e) { const int i = q * 4 + e; hv[e] = Hl[i] + Ac[i] * Hin; av[e] = Ac[i] * Ain; }
          *(f32x4*)(sc + q * 4) = hv; *(f32x4*)(sc + 1024 + q * 4) = av; }
      if (wid == 7) { float* cw = p.lru_carry + (((size_t)b * 4 + h) * 16 + seg) * 128;
          cw[lane * 2] = Ac[15] * Ain; cw[lane * 2 + 1] = Hl[15] + Ac[15] * Hin; } }
}

__device__ __forceinline__ void lru_fix_item(const Params& p, int l, int item) {
    const int tid = opaque_tid(), wid = tid >> 6, lane = tid & 63;
    const int b = item >> 6, h = (item >> 4) & 3, seg = item & 15;
    const int t0 = seg * 128 + wid * 16; const size_t Tb = (size_t)b * SEQ;
    const int ch = h * 64 + lane;
    const float* sc = (const float*)p.hbuf + ((((size_t)b * 4 + h) * 16 + seg) * 8 + wid) * 2048 + lane * 16;
    f32x4 hv[4], av[4]; unsigned gr[16];
#pragma unroll
    for (int q = 0; q < 4; ++q) { hv[q] = *(const f32x4*)(sc + q * 4); av[q] = *(const f32x4*)(sc + 1024 + q * 4); }
#pragma unroll
    for (int i = 0; i < 16; ++i) gr[i] = p.z[(Tb + t0 + i) * ZLD + 2560 + ch];
    const float* car = p.lru_carry + (((size_t)b * 4 + h) * 16) * 128;
    float Hin = 0.f;
#pragma unroll 4
    for (int s = 0; s < seg; ++s) { const float as = car[s * 128 + lane * 2], hs = car[s * 128 + lane * 2 + 1]; Hin = as * Hin + hs; }
#pragma unroll
    for (int i = 0; i < 16; ++i) { const float hvv = hv[i >> 2][i & 3] + av[i >> 2][i & 3] * Hin; const size_t T = Tb + t0 + i;
        p.outs[((size_t)3 * M + T) * 256 + ch] = f2bf(hvv * gelu_t(bf2f(gr[i]))); }
}

__device__ __forceinline__ void hgrn_item(const Params& p, int l, int item, int pass, LAS unsigned char* lds) {
    const int tid = opaque_tid(), wid = tid >> 6, lane = tid & 63, fr = lane & 15, fq = lane >> 4;
    const int b = item >> 5, hp = (item >> 4) & 1, seg = item & 15;
    const int g4 = wid >> 2, wv = wid & 3, head = hp * 2 + g4;
    LAS unsigned char* gb = lds + g4 * 8192;
    LAS bf16_t* Qs = (LAS bf16_t*)gb; LAS bf16_t* Ks = (LAS bf16_t*)(gb + 2304); LAS bf16_t* KHt = (LAS bf16_t*)(gb + 4608);
    LAS float* decs = (LAS float*)(gb + 6656); LAS float* ssq = (LAS float*)(gb + 6912);
    const int kch = head * 64 + wv * 16 + fr;
    const float lbv = p.lbs[l * 256 + kch];
    const size_t iseg = ((size_t)b * 4 + head) * 16;
    f32x4 S[4];
#pragma unroll
    for (int kt = 0; kt < 4; ++kt) S[kt] = ZERO4;
    float segb = 0.f;
    float ng[4] = {0.f, 0.f, 0.f, 0.f};
    if (pass == 1) {
        for (int s = 0; s < seg; ++s) { const float* Sp = p.hgS + (iseg + s) * 4096 + wv * 16 + fr; const float* Dp = p.hgD + (iseg + s) * 64;
#pragma unroll
            for (int kt = 0; kt < 4; ++kt) { const f32x4 dl = *(const f32x4*)(Dp + kt * 16 + fq * 4);
#pragma unroll
                for (int j = 0; j < 4; ++j) S[kt][j] = fexp(dl[j]) * S[kt][j] + Sp[(kt * 16 + fq * 4 + j) * 64]; } }
#pragma unroll
        for (int j = 0; j < 4; ++j) ng[j] = p.hg_norm_g[l * 256 + head * 64 + wv * 16 + fq * 4 + j];
    }
    unsigned qn[4], fn[4], vn[4];
#define HG_LOAD(n_) do { const size_t T0_ = (size_t)b * SEQ + seg * 128 + (n_) * 16; \
        _Pragma("unroll") for (int j = 0; j < 4; ++j) { const bf16_t* zp = p.z + (T0_ + fq * 4 + j) * ZLD; qn[j] = zp[768 + kch]; fn[j] = zp[1024 + kch]; vn[j] = zp[1280 + kch]; } } while (0)
    HG_LOAD(0);
    for (int n = 0; n < 8; ++n) {
        const size_t T0 = (size_t)b * SEQ + seg * 128 + n * 16;
        float qv[4], fz[4]; unsigned vv[4];
#pragma unroll
        for (int j = 0; j < 4; ++j) { qv[j] = bf2f(qn[j]); fz[j] = bf2f(fn[j]); vv[j] = vn[j]; }
        if (n < 7) HG_LOAD(n + 1);
        u32x4 vw; vw.x = vv[0] | (vv[1] << 16); vw.y = vv[2] | (vv[3] << 16); vw.z = 0u; vw.w = 0u; const bf16x8 vfrag = as_bf8(vw);
        float cs[4], kf[4]; float run = 0.f;
#pragma unroll
        for (int j = 0; j < 4; ++j) { const float sg = sigm(fz[j]); const float f = lbv + (1.f - lbv) * sg; run += __logf(fmaxf(f, 1e-30f)); cs[j] = run; kf[j] = (1.f - lbv) * sigm(-fz[j]); }
        { const float t1 = __shfl(run, lane - 16), t2 = __shfl(run, lane - 32), t3 = __shfl(run, lane - 48);
          const float pre = (fq >= 1 ? t1 : 0.f) + (fq >= 2 ? t2 : 0.f) + (fq >= 3 ? t3 : 0.f);
#pragma unroll
          for (int j = 0; j < 4; ++j) cs[j] += pre; }
        const float blast = __shfl(cs[3], 48 + fr);
        lds_barrier();
        { u32x2 w; w.x = pk2(kf[0] * fexp(blast - cs[0]), kf[1] * fexp(blast - cs[1])); w.y = pk2(kf[2] * fexp(blast - cs[2]), kf[3] * fexp(blast - cs[3]));
          *(LAS u32x2*)(KHt + (wv * 16 + fr) * 16 + fq * 4) = w;
          if (fq == 0) decs[wv * 16 + fr] = fexp(blast);
          if (pass == 1) {
#pragma unroll
              for (int j = 0; j < 4; ++j) { const int s = fq * 4 + j; Qs[s * 72 + wv * 16 + fr] = f2bf(silu(qv[j]) * fexp(cs[j])); Ks[s * 72 + wv * 16 + fr] = f2bf(kf[j] * fexp(fminf(-cs[j], 80.f))); } } }
        segb += blast;
        lds_barrier();
        f32x4 o = ZERO4;
        if (pass == 1) {
            const bf16x8 ka0 = *(const LAS bf16x8*)(Ks + fr * 72 + fq * 8), ka1 = *(const LAS bf16x8*)(Ks + fr * 72 + 32 + fq * 8);
            const bf16x8 qb0 = *(const LAS bf16x8*)(Qs + fr * 72 + fq * 8), qb1 = *(const LAS bf16x8*)(Qs + fr * 72 + 32 + fq * 8);
            f32x4 sc = mfma16(ka0, qb0, ZERO4); sc = mfma16(ka1, qb1, sc);
#pragma unroll
            for (int j = 0; j < 4; ++j) sc[j] = (fq * 4 + j <= fr) ? sc[j] : 0.f;
            u32x4 pw; pw.x = pk2(sc[0], sc[1]); pw.y = pk2(sc[2], sc[3]); pw.z = 0u; pw.w = 0u;
            o = mfma16(vfrag, as_bf8(pw), o);
#pragma unroll
            for (int kk = 0; kk < 2; ++kk) {
                u32x4 sw; sw.x = pk2(S[2 * kk][0], S[2 * kk][1]); sw.y = pk2(S[2 * kk][2], S[2 * kk][3]); sw.z = pk2(S[2 * kk + 1][0], S[2 * kk + 1][1]); sw.w = pk2(S[2 * kk + 1][2], S[2 * kk + 1][3]);
                const u32x2 q0 = *(const LAS u32x2*)(Qs + fr * 72 + (2 * kk) * 16 + fq * 4), q1 = *(const LAS u32x2*)(Qs + fr * 72 + (2 * kk + 1) * 16 + fq * 4);
                u32x4 qw; qw.x = q0.x; qw.y = q0.y; qw.z = q1.x; qw.w = q1.y;
                o = mfma16(as_bf8(sw), as_bf8(qw), o);
            }
        }
#pragma unroll
        for (int kt = 0; kt < 4; ++kt) { const u32x2 kh = *(const LAS u32x2*)(KHt + (kt * 16 + fr) * 16 + fq * 4); u32x4 kw; kw.x = kh.x; kw.y = kh.y; kw.z = 0u; kw.w = 0u;
            const f32x4 dv = *(const LAS f32x4*)(decs + kt * 16 + fq * 4); S[kt] = mfma16(as_bf8(kw), vfrag, S[kt] * dv); }
        if (pass == 1) {
            float ss = o[0] * o[0] + o[1] * o[1] + o[2] * o[2] + o[3] * o[3]; ss += __shfl_xor(ss, 16); ss += __shfl_xor(ss, 32);
            if (fq == 0) ssq[wv * 16 + fr] = ss;
            lds_barrier();
            const float tot = ssq[fr] + ssq[16 + fr] + ssq[32 + fr] + ssq[48 + fr]; const float rstd = rsqrtf(tot * (1.f / 64.f) + EPS);
            const size_t T = T0 + fr; const u32x2 gw = *(const u32x2*)(p.z + T * ZLD + 1536 + head * 64 + wv * 16 + fq * 4);
            u32x2 w; w.x = pk2(o[0] * rstd * ng[0] * silu(bflo(gw.x)), o[1] * rstd * ng[1] * silu(bfhi(gw.x)));
            w.y = pk2(o[2] * rstd * ng[2] * silu(bflo(gw.y)), o[3] * rstd * ng[3] * silu(bfhi(gw.y)));
            *(u32x2*)(p.outs + ((size_t)1 * M + T) * 256 + head * 64 + wv * 16 + fq * 4) = w;
        }
    }
    if (pass == 0) {
        float* Sp = p.hgS + (iseg + seg) * 4096 + wv * 16 + fr;
#pragma unroll
        for (int kt = 0; kt < 4; ++kt)
#pragma unroll
            for (int j = 0; j < 4; ++j) Sp[(kt * 16 + fq * 4 + j) * 64] = S[kt][j];
        if (fq == 0) p.hgD[(iseg + seg) * 64 + wv * 16 + fr] = segb;
    }
    lds_barrier();
}

__device__ __forceinline__ void bgemm_phase(LAS unsigned char* lds, const bf16_t* outs, const bf16_t* wbr, const bf16_t* zg, bf16_t* merged) {
    using namespace pg8;
    const int tid = opaque_tid(), wid = __builtin_amdgcn_readfirstlane(tid >> 6), lane = tid & 63, fr = lane & 15, fq = lane >> 4;
    const int wm = wid >> 1, wn = wid & 1;
    unsigned voff[2], voffB[2];
#pragma unroll
    for (int i = 0; i < 2; ++i) { int R, C; stage_rc(tid * 16 + i * 8192, R, C); voff[i] = (unsigned)(R * 256 + C) * 2u; voffB[i] = (unsigned)(((R & ~31) + perm32(R & 31)) * 256 + C) * 2u; }
    const unsigned ldsw = (unsigned)wid * 1024u;
    const int aoff = (wm >> 1) * HTB + lds_byte((wm & 1) * 64 + fr, fq * 8);
    const int boff = 2 * HTB + lds_byte(wn * 64 + fr, fq * 8);
    constexpr int STG = 3 * HTB;
#define BG_LDX(dstoff, gbase, vo) do { _Pragma("unroll") for (int _i = 0; _i < 2; ++_i) \
        __builtin_amdgcn_global_load_lds((const unsigned*)((const char*)(gbase) + (vo)[_i]), (LAS unsigned*)(lds + (dstoff) + ldsw + _i * 8192), 16, 0, 0); } while (0)
#define BG_LD(dstoff, gbase) BG_LDX(dstoff, gbase, voff)
#define BG_STAGE(kk_, slot_) do { const int _n = (kk_) >> 2, _kt = (kk_) & 3; const int _so = (slot_) * STG; \
        const bf16_t* _a = outs + ((size_t)_n * M + (size_t)pm * 256) * 256 + _kt * 64; const bf16_t* _b = wbr + ((size_t)_n * 1024 + (size_t)pn * 128) * 256 + _kt * 64; \
        BG_LD(_so, _a); BG_LD(_so + HTB, _a + 128 * 256); BG_LDX(_so + 2 * HTB, _b, voffB); } while (0)
#define BG_COMPUTE(slot_) do { const LAS unsigned char* sb = lds + (slot_) * STG; \
        _Pragma("unroll") for (int k = 0; k < 2; ++k) { bf16x8 af[4], bw[4]; \
            _Pragma("unroll") for (int mi = 0; mi < 4; ++mi) af[mi] = *(const LAS bf16x8*)(sb + aoff + mi * 2048 + k * 1024); \
            _Pragma("unroll") for (int ni = 0; ni < 4; ++ni) bw[ni] = *(const LAS bf16x8*)(sb + boff + ni * 2048 + k * 1024); \
            _Pragma("unroll") for (int mi = 0; mi < 4; ++mi) _Pragma("unroll") for (int ni = 0; ni < 4; ++ni) acc[mi][ni] = mfma16(bw[ni], af[mi], acc[mi][ni]); } } while (0)
#define BG_WAIT(n) asm volatile("s_waitcnt vmcnt(" #n ")" ::: "memory")
#define BG_BAR() do { __builtin_amdgcn_s_barrier(); asm volatile("" ::: "memory"); } while (0)
    for (int u = opaque_bid(); u < 512; u += opaque_gd()) {
        const int up = (u & ~255) + (u & 7) * 32 + ((u & 255) >> 3);
        const int pm = up >> 3, pn = up & 7;
        f32x4 tot[4][4], acc[4][4];
#pragma unroll
        for (int mi = 0; mi < 4; ++mi)
#pragma unroll
            for (int ni = 0; ni < 4; ++ni) { tot[mi][ni] = ZERO4; acc[mi][ni] = ZERO4; }
        BG_STAGE(0, 0); BG_STAGE(1, 1);
        int slot = 0;
        for (int n = 0; n < 4; ++n) {
            const int kk0 = n * 4;
            BG_WAIT(6); BG_BAR(); { const int s2 = slot >= 1 ? slot - 1 : 2; BG_STAGE(kk0 + 2, s2); } BG_COMPUTE(slot); slot = slot == 2 ? 0 : slot + 1;
            BG_WAIT(6); BG_BAR(); { const int s2 = slot >= 1 ? slot - 1 : 2; BG_STAGE(kk0 + 3, s2); } BG_COMPUTE(slot); slot = slot == 2 ? 0 : slot + 1;
            BG_WAIT(6); BG_BAR(); if (n < 3) { const int s2 = slot >= 1 ? slot - 1 : 2; BG_STAGE(kk0 + 4, s2); } BG_COMPUTE(slot); slot = slot == 2 ? 0 : slot + 1;
            if (n < 3) { BG_WAIT(6); } else { BG_WAIT(0); }
            BG_BAR(); if (n < 3) { const int s2 = slot >= 1 ? slot - 1 : 2; BG_STAGE(kk0 + 5, s2); }
            size_t goff = (((size_t)n * 64 + pm) * 8 + pn) * 32768 + (size_t)(((wm * 4) * 4 + wn * 2) * 64 + fq * 16 + fr) * 8;
            asm volatile("" : "+v"(goff) :: "memory");
            const bf16_t* gp0 = zg + goff;
            u32x4 gv[2][2];
#pragma unroll
            for (int mi = 0; mi < 2; ++mi)
#pragma unroll
                for (int g = 0; g < 2; ++g) gv[mi][g] = *(const u32x4*)(gp0 + (mi * 4 + g) * 512);
            BG_COMPUTE(slot); slot = slot == 2 ? 0 : slot + 1;
#pragma unroll
            for (int hf = 0; hf < 2; ++hf) {
                u32x4 gn[2][2];
                if (hf == 0) {
#pragma unroll
                    for (int mi = 0; mi < 2; ++mi)
#pragma unroll
                        for (int g = 0; g < 2; ++g) gn[mi][g] = *(const u32x4*)(gp0 + ((2 + mi) * 4 + g) * 512);
                }
#pragma unroll
                for (int mi = 0; mi < 2; ++mi)
#pragma unroll
                    for (int g = 0; g < 2; ++g) { const u32x4 gq = gv[mi][g]; const int m2 = hf * 2 + mi;
                        tot[m2][2 * g][0] += sigm(bflo(gq.x)) * acc[m2][2 * g][0]; tot[m2][2 * g][1] += sigm(bfhi(gq.x)) * acc[m2][2 * g][1];
                        tot[m2][2 * g][2] += sigm(bflo(gq.y)) * acc[m2][2 * g][2]; tot[m2][2 * g][3] += sigm(bfhi(gq.y)) * acc[m2][2 * g][3];
                        tot[m2][2 * g + 1][0] += sigm(bflo(gq.z)) * acc[m2][2 * g + 1][0]; tot[m2][2 * g + 1][1] += sigm(bfhi(gq.z)) * acc[m2][2 * g + 1][1];
                        tot[m2][2 * g + 1][2] += sigm(bflo(gq.w)) * acc[m2][2 * g + 1][2]; tot[m2][2 * g + 1][3] += sigm(bfhi(gq.w)) * acc[m2][2 * g + 1][3];
                        acc[m2][2 * g] = ZERO4; acc[m2][2 * g + 1] = ZERO4; }
                if (hf == 0) {
#pragma unroll
                    for (int mi = 0; mi < 2; ++mi)
#pragma unroll
                        for (int g = 0; g < 2; ++g) gv[mi][g] = gn[mi][g];
                }
            }
        }
#pragma unroll
        for (int mi = 0; mi < 4; ++mi) { size_t ooff = (size_t)(pm * 256 + wm * 64 + mi * 16 + fr) * D + pn * 128 + wn * 64 + fq * 8; asm volatile("" : "+v"(ooff)); bf16_t* op = merged + ooff;
#pragma unroll
            for (int g = 0; g < 2; ++g) { u32x4 w; w.x = pk2(tot[mi][2 * g][0], tot[mi][2 * g][1]); w.y = pk2(tot[mi][2 * g][2], tot[mi][2 * g][3]);
                w.z = pk2(tot[mi][2 * g + 1][0], tot[mi][2 * g + 1][1]); w.w = pk2(tot[mi][2 * g + 1][2], tot[mi][2 * g + 1][3]); *(u32x4*)(op + g * 32) = w; } }
        BG_BAR();
    }
    asm volatile("s_waitcnt vmcnt(0)" ::: "memory"); __syncthreads();
#undef BG_LD
#undef BG_LDX
#undef BG_STAGE
#undef BG_COMPUTE
#undef BG_WAIT
#undef BG_BAR
}

__device__ __forceinline__ void run_phase(const LAS Params* lp, int ph, LAS unsigned char* lds) {
    if (ph == 0) { const Params p = fetchP(lp); phase0(p, lds); return; }
    const int l = (ph - 1) / 7, s = (ph - 1) - l * 7;
    const int G = opaque_gd(), c = opaque_bid();
    switch (s) {
    case 0: { const Params p = fetchP(lp); pg8::Gemm g{p.hbuf, p.wt_in + (size_t)l * 6912 * 1024, M, 6912, 1024, 30, 0}; pg8::EpiZG E{p.z, p.z + ZG_OFF}; pg8::gemm_phase(lds, g, G, c, E);
              if (l < 3 && G == 256 && c >= 192) conv_range(p, lds, (l + 1) * 4352, (l + 1) * 4352 + 1152, c - 192, 64); } break;
    case 1: for (int it = opaque_bid(); it < 1280; it += opaque_gd()) { const Params p = fetchP(lp); const int jx = (it & ~255) + (it & 7) * 32 + ((it & 255) >> 3);
            if (it < 256) hgrn_item(p, l, jx, 0, lds); else if (it < 768) attn_item(p, l, jx - 256, lds); else lru_item(p, l, jx - 768, lds); } break;
    case 2: for (int it = opaque_bid(); it < 1280; it += opaque_gd()) { const Params p = fetchP(lp); const int jx = (it & ~255) + (it & 7) * 32 + ((it & 255) >> 3);
            if (it < 256) hgrn_item(p, l, jx, 1, lds); else if (it < 768) gmlp_item(p, l, jx - 256, lds); else lru_fix_item(p, l, jx - 768); } break;
    case 3: { const Params p = fetchP(lp); bgemm_phase(lds, p.outs, p.wt_br + (size_t)l * 4096 * 256, p.z + ZG_OFF, p.hbuf); } break;
    case 4: { const Params p = fetchP(lp); pg8::Gemm g{p.hbuf, p.wt_out + (size_t)l * 1024 * 1024, M, 1024, 1024, 30, 0};
              const unsigned tgt = 32u * (unsigned)(2 * l + 1);
              pg8::EpiRms E{l == 0 ? p.x_in : (const float*)p.x, p.x, p.n_mix_post + l * D, p.n_ffn_pre + l * D, p.hbuf, {p.xslot, p.xcnt, tgt}, {p.xslot + 65536, p.xcnt + 4096, tgt}, l != 0, 1}; pg8::gemm_phase(lds, g, G, c, E); } break;
    case 5: { const Params p = fetchP(lp); pg8::Gemm g{p.hbuf, p.wt_f1 + (size_t)l * 5632 * 1024, M, 5632, 1024, 30, 0}; pg8::EpiSwi E{p.act, FF}; pg8::gemm_phase(lds, g, G, c, E);
              if (l < 3 && G == 256 && c >= 128) conv_range(p, lds, (l + 1) * 4352 + 1152, (l + 2) * 4352, c - 128, 128);
              if (l < 3 && G != 256) { conv_range(p, lds, (l + 1) * 4352, (l + 2) * 4352, c, G); } } break;
    default: { const Params p = fetchP(lp); pg8::Gemm g{p.act, p.wt_f2 + (size_t)l * 1024 * 2816, M, 1024, 2816, 30, 0};
              const unsigned tgt = 32u * (unsigned)(2 * l + 2);
              pg8::EpiRms E{p.x, p.x, p.n_ffn_post + l * D, l < 3 ? p.n_mix_pre + (l + 1) * D : nullptr, l < 3 ? p.hbuf : nullptr, {p.xslot, p.xcnt, tgt}, {p.xslot + 65536, p.xcnt + 4096, tgt}, 1, l < 3}; pg8::gemm_phase(lds, g, G, c, E); } break;
    }
}

__global__ void __launch_bounds__(512, 2) mega(Params p) {
    extern __shared__ __attribute__((aligned(16))) unsigned char smem[];
    LAS unsigned char* lds = (LAS unsigned char*)smem;
    LAS Params* lp = (LAS Params*)(lds + P_OFF);
    { const __attribute__((address_space(4))) unsigned long long* ka = (const __attribute__((address_space(4))) unsigned long long*)__builtin_amdgcn_kernarg_segment_ptr();
      if (threadIdx.x < sizeof(Params) / 8) ((LAS unsigned long long*)lp)[threadIdx.x] = ka[threadIdx.x]; }
    __syncthreads();
    cg::grid_group grid = cg::this_grid();
    volatile LAS unsigned* bst = (volatile LAS unsigned*)(lds + P_OFF + 448);
    if (threadIdx.x == 0) { bst[0] = 0u; bst[1] = 0u; }
    __syncthreads();
    const int lo = __builtin_amdgcn_readfirstlane(lp->ph_lo), hi = __builtin_amdgcn_readfirstlane(lp->ph_hi);
    if (hi - lo > 1 && threadIdx.x == 0) (void)xb_add(&((unsigned*)lds_u64(&lp->bar))[XB_XCNT(xb_xcc_id())], 1u);
#define GSYNC() xcd_barrier((unsigned*)lds_u64(&lp->bar), bst)
    for (int ph = lo; ph < hi; ++ph) {
        if (ph > lo) { if (hi > 4096) grid.sync(); else GSYNC(); }
        run_phase(lp, ph, lds);
#if 0
#endif
    }
}

extern "C" void kernel_launch(void* const* d_in, const int* in_sizes, int n_in, void* d_out, int out_size, void* d_ws, size_t ws_size, hipStream_t stream) {
    static int grid_blocks = 0;
    if (!grid_blocks) {
        int dev = 0, cus = 0, per_cu = 0;
        hipGetDevice(&dev);
        hipDeviceGetAttribute(&cus, hipDeviceAttributeMultiprocessorCount, dev);
        if (hipFuncSetAttribute((const void*)mega, hipFuncAttributeMaxDynamicSharedMemorySize, LDS_BYTES) != hipSuccess) { fprintf(stderr, "hipFuncSetAttribute failed\n"); grid_blocks = -1; return; }
        hipOccupancyMaxActiveBlocksPerMultiprocessor(&per_cu, (const void*)mega, 512, LDS_BYTES);
        if (per_cu < 1) { fprintf(stderr, "occupancy query says %d blocks per CU\n", per_cu); per_cu = 1; }
        (void)hipGetLastError();
        grid_blocks = cus * per_cu;
        if (n_in != 23 || ws_size < WS_END) { fprintf(stderr, "bad problem: n_in %d ws %zu need %zu\n", n_in, ws_size, (size_t)WS_END); grid_blocks = -1; }
    }
    if (grid_blocks < 0) return;
    Params p{};
    const float** f = (const float**)&p;
    for (int i = 0; i < 23; ++i) f[i] = (const float*)d_in[i];
    unsigned char* ws = (unsigned char*)d_ws;
    p.x = (float*)d_out;
    p.wt_in = (bf16_t*)(ws + OFF_WIN); p.wt_br = (bf16_t*)(ws + OFF_WBR); p.wt_out = (bf16_t*)(ws + OFF_WOUT); p.wt_f1 = (bf16_t*)(ws + OFF_WF1); p.wt_f2 = (bf16_t*)(ws + OFF_WF2);
    p.z = (bf16_t*)(ws + OFF_Z); p.hbuf = (bf16_t*)(ws + OFF_H); p.outs = (bf16_t*)(ws + OFF_OUTS); p.act = (bf16_t*)(ws + OFF_ACT);
    p.gmw = (bf16_t*)(ws + OFF_GMW); p.waT = (bf16_t*)(ws + OFF_WAT); p.wxT = (bf16_t*)(ws + OFF_WXT);
    p.y = (float*)(ws + OFF_Y); p.lbs = (float*)(ws + OFF_LBS); p.spl = (float*)(ws + OFF_SPL); p.lru_carry = (float*)(ws + OFF_LCAR); p.hgS = (float*)(ws + OFF_HGS); p.hgD = (float*)(ws + OFF_HGD); p.bar = (unsigned*)(ws + OFF_BAR); p.xcnt = (unsigned*)(ws + OFF_XCNT); p.xslot = (float*)(ws + OFF_XSLOT);
    (void)hipMemsetAsync(ws + OFF_BAR, 0, 16384 + 32768, stream);
#if MULTI_LAUNCH
    for (int ph = 0; ph < NPHASE; ++ph) { p.ph_lo = ph; p.ph_hi = ph + 1; hipLaunchKernelGGL(mega, dim3(grid_blocks), dim3(512), LDS_BYTES, stream, p); }
#else
    p.ph_lo = 0; p.ph_hi = NPHASE;
    void* args[] = {&p};
    hipError_t e = hipLaunchCooperativeKernel((const void*)mega, dim3(grid_blocks), dim3(512), args, LDS_BYTES, stream);
    if (e != hipSuccess) fprintf(stderr, "cooperative launch failed: %s (grid %d)\n", hipGetErrorString(e), grid_blocks);
#endif
}
```
